# Optimizing an MI355X kernel written in HIP

```python
import jax, jax.numpy as jnp
from jax import lax
import numpy as np

D_MODEL = 1024
BATCH = 4
SEQ = 4096
DEPTH = 4

CHUNK = 64
N_A_LAYERS = DEPTH // 2
N_B_LAYERS = DEPTH - N_A_LAYERS
GMLP_BLOCK = 128
GMLP_WIDTH = D_MODEL
GMLP_GROUPS = 8
GMLP_GROUP_DIM = GMLP_WIDTH // GMLP_GROUPS
ATTN_HEADS = 16
HEAD_DIM = D_MODEL // ATTN_HEADS
LEFT_CHUNKS = 8
BAND_CHUNKS = LEFT_CHUNKS + 1
BAND = BAND_CHUNKS * CHUNK
REL_CLIP = 256
FFN_HIDDEN = 4 * D_MODEL
RMS_EPS = 1e-6
LN_EPS = 1e-5
NEG_INF = -1e30

kernel_name = "yoco_gmlp_chunk_relbias_attn_trunk"


def rms_norm(x, g):
    xf = x.astype(jnp.float32)
    y = xf * lax.rsqrt(jnp.mean(xf * xf, axis=-1, keepdims=True) + RMS_EPS)
    return (y * g.astype(jnp.float32)).astype(x.dtype)


def layer_norm(x, g, b):
    xf = x.astype(jnp.float32)
    mu = jnp.mean(xf, axis=-1, keepdims=True)
    xc = xf - mu
    var = jnp.mean(xc * xc, axis=-1, keepdims=True)
    y = xc * lax.rsqrt(var + LN_EPS) * g.astype(jnp.float32) + b.astype(jnp.float32)
    return y.astype(x.dtype)


def gmlp_spatial_gating(h, w_in, ln_g, ln_b, w_s, b_s, w_out):
    bsz, seq, _ = h.shape
    nblk = seq // GMLP_BLOCK
    uv = jax.nn.gelu(h @ w_in)
    u, v = jnp.split(uv, 2, axis=-1)
    v = layer_norm(v, ln_g, ln_b)
    v = v.reshape(bsz, nblk, GMLP_BLOCK, GMLP_GROUPS, GMLP_GROUP_DIM)
    chunk_id = jnp.arange(GMLP_BLOCK) // CHUNK
    mask = chunk_id[:, None] >= chunk_id[None, :]
    w_masked = jnp.where(mask[None], w_s, jnp.zeros((), w_s.dtype))
    sv = jnp.einsum('gij,bnjgd->bnigd', w_masked, v)
    sv = sv + jnp.transpose(b_s)[None, None, :, :, None]
    gate = sv.reshape(bsz, seq, GMLP_WIDTH)
    return (u * gate) @ w_out


def shared_kv_band(h, kv_norm_g, w_k, w_v):
    bsz, seq, _ = h.shape
    nc = seq // CHUNK
    hn = rms_norm(h, kv_norm_g)
    k = (hn @ w_k).reshape(bsz, nc, CHUNK, ATTN_HEADS, HEAD_DIM)
    v = (hn @ w_v).reshape(bsz, nc, CHUNK, ATTN_HEADS, HEAD_DIM)

    def band(t):
        tp = jnp.pad(t, ((0, 0), (LEFT_CHUNKS, 0), (0, 0), (0, 0), (0, 0)))
        tb = jnp.stack([tp[:, o:o + nc] for o in range(BAND_CHUNKS)], axis=2)
        return tb.reshape(bsz, nc, BAND, ATTN_HEADS, HEAD_DIM)

    key_chunk = jnp.arange(nc)[:, None] + jnp.arange(BAND_CHUNKS)[None, :] - LEFT_CHUNKS
    valid = jnp.repeat(key_chunk >= 0, CHUNK, axis=1)
    return band(k), band(v), valid


def relative_bias(table):
    q_pos = jnp.arange(CHUNK)[:, None] + LEFT_CHUNKS * CHUNK
    k_pos = jnp.arange(BAND)[None, :]
    idx = jnp.clip(q_pos - k_pos, -REL_CLIP, REL_CLIP) + REL_CLIP
    return table[:, idx]


def chunk_band_attention(h, w_q, rel_table, w_o, k_band, v_band, valid):
    bsz, seq, _ = h.shape
    nc = seq // CHUNK
    q = (h @ w_q).reshape(bsz, nc, CHUNK, ATTN_HEADS, HEAD_DIM)
    s = jnp.einsum('bcqhd,bckhd->bchqk', q, k_band).astype(jnp.float32)
    s = s * (HEAD_DIM ** -0.5) + relative_bias(rel_table).astype(jnp.float32)[None, None]
    s = jnp.where(valid[None, :, None, None, :], s, NEG_INF)
    p = jax.nn.softmax(s, axis=-1).astype(h.dtype)
    o = jnp.einsum('bchqk,bckhd->bcqhd', p, v_band).reshape(bsz, seq, D_MODEL)
    return o @ w_o


def sq_relu_mlp(h, w_up, w_down):
    return jnp.square(jax.nn.relu(h @ w_up)) @ w_down


def setup_inputs(seed: int = 0) -> dict:
    key = jax.random.key(seed)
    ks = jax.random.split(key, 16)
    nrm = jax.random.normal
    D, W, G, H = D_MODEL, GMLP_WIDTH, GMLP_GROUPS, ATTN_HEADS
    return {
        "x": nrm(ks[0], (BATCH, SEQ, D), jnp.float32),
        "norm_g": 1.0 + 0.1 * nrm(ks[1], (DEPTH, 4, D), jnp.float32),
        "a_w_in": nrm(ks[2], (N_A_LAYERS, D, 2 * W), jnp.float32) * D ** -0.5,
        "a_ln_g": 1.0 + 0.1 * nrm(ks[3], (N_A_LAYERS, W), jnp.float32),
        "a_ln_b": 0.02 * nrm(ks[4], (N_A_LAYERS, W), jnp.float32),
        "a_w_s": nrm(ks[5], (N_A_LAYERS, G, GMLP_BLOCK, GMLP_BLOCK), jnp.float32) * GMLP_BLOCK ** -0.5,
        "a_b_s": 1.0 + 0.1 * nrm(ks[6], (N_A_LAYERS, G, GMLP_BLOCK), jnp.float32),
        "a_w_out": nrm(ks[7], (N_A_LAYERS, W, D), jnp.float32) * W ** -0.5,
        "kv_norm_g": 1.0 + 0.1 * nrm(ks[8], (D,), jnp.float32),
        "w_k": nrm(ks[9], (D, D), jnp.float32) * D ** -0.5,
        "w_v": nrm(ks[10], (D, D), jnp.float32) * D ** -0.5,
        "b_w_q": nrm(ks[11], (N_B_LAYERS, D, D), jnp.float32) * D ** -0.5,
        "b_rel_bias": 0.5 * nrm(ks[12], (N_B_LAYERS, H, 2 * REL_CLIP + 1), jnp.float32),
        "b_w_o": nrm(ks[13], (N_B_LAYERS, D, D), jnp.float32) * D ** -0.5,
        "w_up": nrm(ks[14], (DEPTH, D, FFN_HIDDEN), jnp.float32) * D ** -0.5,
        "w_down": nrm(ks[15], (DEPTH, FFN_HIDDEN, D), jnp.float32) * FFN_HIDDEN ** -0.5,
    }


def reference(x, norm_g, a_w_in, a_ln_g, a_ln_b, a_w_s, a_b_s, a_w_out,
              kv_norm_g, w_k, w_v, b_w_q, b_rel_bias, b_w_o, w_up, w_down):
    h = x
    k_band = v_band = valid = None
    for layer in range(DEPTH):
        g = norm_g[layer]
        if layer < N_A_LAYERS:
            m = gmlp_spatial_gating(rms_norm(h, g[0]), a_w_in[layer], a_ln_g[layer],
                                    a_ln_b[layer], a_w_s[layer], a_b_s[layer], a_w_out[layer])
        else:
            if layer == N_A_LAYERS:
                k_band, v_band, valid = shared_kv_band(h, kv_norm_g, w_k, w_v)
            j = layer - N_A_LAYERS
            m = chunk_band_attention(rms_norm(h, g[0]), b_w_q[j], b_rel_bias[j], b_w_o[j],
                                     k_band, v_band, valid)
        h = h + rms_norm(m, g[1])
        f = sq_relu_mlp(rms_norm(h, g[2]), w_up[layer], w_down[layer])
        h = h + rms_norm(f, g[3])
    return h
```

```cpp
#include <hip/hip_runtime.h>
#include <cstdio>
#include <cstdint>

namespace nv {
constexpr int D = 1024, SEQ = 4096, NB = 4, FF = 4096, H = 16, HD = 64, CH = 64;

template <int MODE>
__global__ void __launch_bounds__(256) rms_rows(const float* in, const float* g, float* out, float* res) {
    const int row = blockIdx.x, tid = threadIdx.x;
    const float4 v = ((const float4*)(in + (size_t)row * D))[tid];
    float s = v.x * v.x + v.y * v.y + v.z * v.z + v.w * v.w;
    __shared__ float red[4];
    for (int o = 32; o > 0; o >>= 1) s += __shfl_xor(s, o);
    if ((tid & 63) == 0) red[tid >> 6] = s;
    __syncthreads();
    s = red[0] + red[1] + red[2] + red[3];
    const float r = 1.0f / sqrtf(s * (1.0f / D) + 1e-6f);
    const float4 gg = ((const float4*)g)[tid];
    float4 o; o.x = v.x * r * gg.x; o.y = v.y * r * gg.y; o.z = v.z * r * gg.z; o.w = v.w * r * gg.w;
    if (MODE == 0) ((float4*)(out + (size_t)row * D))[tid] = o;
    else { float4 h = ((float4*)(res + (size_t)row * D))[tid]; h.x += o.x; h.y += o.y; h.z += o.z; h.w += o.w; ((float4*)(res + (size_t)row * D))[tid] = h; }
}

__global__ void __launch_bounds__(256) ln_rows(float* uv, const float* g, const float* b) {
    const int row = blockIdx.x, tid = threadIdx.x;
    float* p = uv + (size_t)row * 2048 + 1024;
    const float4 v = ((const float4*)p)[tid];
    __shared__ float red[4]; __shared__ float red2[4];
    float s = v.x + v.y + v.z + v.w;
    for (int o = 32; o > 0; o >>= 1) s += __shfl_xor(s, o);
    if ((tid & 63) == 0) red[tid >> 6] = s;
    __syncthreads();
    const float mu = (red[0] + red[1] + red[2] + red[3]) * (1.0f / D);
    const float a = v.x - mu, bb = v.y - mu, c = v.z - mu, d = v.w - mu;
    float q = a * a + bb * bb + c * c + d * d;
    for (int o = 32; o > 0; o >>= 1) q += __shfl_xor(q, o);
    if ((tid & 63) == 0) red2[tid >> 6] = q;
    __syncthreads();
    const float r = 1.0f / sqrtf((red2[0] + red2[1] + red2[2] + red2[3]) * (1.0f / D) + 1e-5f);
    const float4 gg = ((const float4*)g)[tid], be = ((const float4*)b)[tid];
    float4 o; o.x = a * r * gg.x + be.x; o.y = bb * r * gg.y + be.y; o.z = c * r * gg.z + be.z; o.w = d * r * gg.w + be.w;
    ((float4*)p)[tid] = o;
}

__device__ __forceinline__ float gelu_tanh(float x) {
    const float u = 0.7978845608028654f * (x + 0.044715f * x * x * x);
    return 0.5f * x * (1.0f + tanhf(u));
}

template <int ACT>
__global__ void __launch_bounds__(256) sgemm(const float* __restrict__ A, const float* __restrict__ W, float* __restrict__ C, int M, int N, int K) {
    __shared__ float As[8][132];
    __shared__ float Bs[8][128];
    const int tid = threadIdx.x, tx = tid & 15, ty = tid >> 4;
    const int m0 = blockIdx.y * 128, n0 = blockIdx.x * 128;
    float acc[8][8];
#pragma unroll
    for (int i = 0; i < 8; ++i)
#pragma unroll
        for (int j = 0; j < 8; ++j) acc[i][j] = 0.f;
    const int ar = tid >> 1, ac = (tid & 1) * 4, br = tid >> 5, bc = (tid & 31) * 4;
    for (int k0 = 0; k0 < K; k0 += 8) {
        const float4 av = *(const float4*)(A + (size_t)(m0 + ar) * K + k0 + ac);
        const float4 bv = *(const float4*)(W + (size_t)(k0 + br) * N + n0 + bc);
        __syncthreads();
        As[ac + 0][ar] = av.x; As[ac + 1][ar] = av.y; As[ac + 2][ar] = av.z; As[ac + 3][ar] = av.w;
        *(float4*)&Bs[br][bc] = bv;
        __syncthreads();
#pragma unroll
        for (int k = 0; k < 8; ++k) {
            float a[8], b[8];
            const float4 a0 = *(const float4*)&As[k][ty * 8], a1 = *(const float4*)&As[k][ty * 8 + 4];
            const float4 b0 = *(const float4*)&Bs[k][tx * 8], b1 = *(const float4*)&Bs[k][tx * 8 + 4];
            a[0] = a0.x; a[1] = a0.y; a[2] = a0.z; a[3] = a0.w; a[4] = a1.x; a[5] = a1.y; a[6] = a1.z; a[7] = a1.w;
            b[0] = b0.x; b[1] = b0.y; b[2] = b0.z; b[3] = b0.w; b[4] = b1.x; b[5] = b1.y; b[6] = b1.z; b[7] = b1.w;
#pragma unroll
            for (int i = 0; i < 8; ++i)
#pragma unroll
                for (int j = 0; j < 8; ++j) acc[i][j] += a[i] * b[j];
        }
    }
#pragma unroll
    for (int i = 0; i < 8; ++i) {
        float o[8];
#pragma unroll
        for (int j = 0; j < 8; ++j) {
            float v = acc[i][j];
            if (ACT == 1) v = gelu_tanh(v);
            if (ACT == 2) { v = v > 0.f ? v : 0.f; v = v * v; }
            o[j] = v;
        }
        float* cp = C + (size_t)(m0 + ty * 8 + i) * N + n0 + tx * 8;
        *(float4*)cp = make_float4(o[0], o[1], o[2], o[3]);
        *(float4*)(cp + 4) = make_float4(o[4], o[5], o[6], o[7]);
    }
}

__global__ void __launch_bounds__(256) gate_k(const float* uv, const float* w_s, const float* b_s, float* ug) {
    const int m = blockIdx.x, i = m & 127, blk = m >> 7;
    const int jn = (i < 64) ? 64 : 128;
    for (int ch = threadIdx.x; ch < 1024; ch += 256) {
        const int g = ch >> 7;
        const float* w = w_s + ((size_t)g * 128 + i) * 128;
        const float* vp = uv + (size_t)blk * 128 * 2048 + 1024 + ch;
        float s = 0.f;
        for (int j = 0; j < jn; ++j) s += w[j] * vp[(size_t)j * 2048];
        s += b_s[g * 128 + i];
        ug[(size_t)m * 1024 + ch] = uv[(size_t)m * 2048 + ch] * s;
    }
}

__global__ void __launch_bounds__(64) attn_k(const float* q, const float* k, const float* v, const float* tbl, float* o) {
    const int c = blockIdx.x, h = blockIdx.y, qi = threadIdx.x;
    const int tq = c * 64 + qi;
    float qr[64], acc[64];
#pragma unroll
    for (int d = 0; d < 64; ++d) { qr[d] = q[(size_t)tq * 1024 + h * 64 + d] * 0.125f; acc[d] = 0.f; }
    float mx = -1e30f, l = 0.f;
    const float* tb = tbl + h * 513;
    const int kc0 = c - 8 < 0 ? 0 : c - 8;
    for (int kc = kc0; kc <= c; ++kc) {
        for (int kj = 0; kj < 64; ++kj) {
            const int tk = kc * 64 + kj;
            const float* kp = k + (size_t)tk * 1024 + h * 64;
            float s = 0.f;
#pragma unroll
            for (int d = 0; d < 64; ++d) s += qr[d] * kp[d];
            int dist = tq - tk; dist = dist > 256 ? 256 : (dist < -256 ? -256 : dist);
            s += tb[dist + 256];
            const float mn = s > mx ? s : mx;
            const float f = expf(mx - mn), p = expf(s - mn);
            l = l * f + p;
            const float* vp = v + (size_t)tk * 1024 + h * 64;
#pragma unroll
            for (int d = 0; d < 64; ++d) acc[d] = acc[d] * f + p * vp[d];
            mx = mn;
        }
    }
    const float il = 1.0f / l;
#pragma unroll
    for (int d = 0; d < 64; ++d) o[(size_t)tq * 1024 + h * 64 + d] = acc[d] * il;
}
}

extern "C" void kernel_launch(void* const* d_in, const int* in_sizes, int n_in, void* d_out, int out_size, void* d_ws, size_t ws_size, hipStream_t stream) {
    using namespace nv;
    const float* x = (const float*)d_in[0];
    const float* norm_g = (const float*)d_in[1];
    const float* a_w_in = (const float*)d_in[2];
    const float* a_ln_g = (const float*)d_in[3];
    const float* a_ln_b = (const float*)d_in[4];
    const float* a_w_s = (const float*)d_in[5];
    const float* a_b_s = (const float*)d_in[6];
    const float* a_w_out = (const float*)d_in[7];
    const float* kv_norm_g = (const float*)d_in[8];
    const float* w_k = (const float*)d_in[9];
    const float* w_v = (const float*)d_in[10];
    const float* b_w_q = (const float*)d_in[11];
    const float* b_rel = (const float*)d_in[12];
    const float* b_w_o = (const float*)d_in[13];
    const float* w_up = (const float*)d_in[14];
    const float* w_down = (const float*)d_in[15];
    float* out = (float*)d_out;
    char* ws = (char*)d_ws;
    const size_t MiB = 1u << 20;
    if (ws_size < 208 * MiB) { fprintf(stderr, "ws too small %zu\n", ws_size); return; }
    float* hn = (float*)(ws + 0 * MiB);
    float* uv = (float*)(ws + 16 * MiB);
    float* ug = (float*)(ws + 48 * MiB);
    float* mm = (float*)(ws + 64 * MiB);
    float* tt = (float*)(ws + 80 * MiB);
    float* qq = (float*)(ws + 144 * MiB);
    float* kk = (float*)(ws + 160 * MiB);
    float* vv = (float*)(ws + 176 * MiB);
    float* oo = (float*)(ws + 192 * MiB);
    hipMemcpyAsync(out, x, (size_t)NB * SEQ * D * 4, hipMemcpyDeviceToDevice, stream);
    const int M = SEQ;
    for (int b = 0; b < NB; ++b) {
        float* h = out + (size_t)b * SEQ * D;
        for (int layer = 0; layer < 4; ++layer) {
            const float* g = norm_g + (size_t)layer * 4 * D;
            rms_rows<0><<<M, 256, 0, stream>>>(h, g, hn, nullptr);
            if (layer < 2) {
                sgemm<1><<<dim3(2048 / 128, M / 128), 256, 0, stream>>>(hn, a_w_in + (size_t)layer * D * 2048, uv, M, 2048, D);
                ln_rows<<<M, 256, 0, stream>>>(uv, a_ln_g + layer * D, a_ln_b + layer * D);
                gate_k<<<M, 256, 0, stream>>>(uv, a_w_s + (size_t)layer * 8 * 128 * 128, a_b_s + layer * 8 * 128, ug);
                sgemm<0><<<dim3(D / 128, M / 128), 256, 0, stream>>>(ug, a_w_out + (size_t)layer * D * D, mm, M, D, D);
            } else {
                const int j = layer - 2;
                if (layer == 2) {
                    rms_rows<0><<<M, 256, 0, stream>>>(h, kv_norm_g, ug, nullptr);
                    sgemm<0><<<dim3(D / 128, M / 128), 256, 0, stream>>>(ug, w_k, kk, M, D, D);
                    sgemm<0><<<dim3(D / 128, M / 128), 256, 0, stream>>>(ug, w_v, vv, M, D, D);
                }
                sgemm<0><<<dim3(D / 128, M / 128), 256, 0, stream>>>(hn, b_w_q + (size_t)j * D * D, qq, M, D, D);
                attn_k<<<dim3(SEQ / 64, H), 64, 0, stream>>>(qq, kk, vv, b_rel + (size_t)j * H * 513, oo);
                sgemm<0><<<dim3(D / 128, M / 128), 256, 0, stream>>>(oo, b_w_o + (size_t)j * D * D, mm, M, D, D);
            }
            rms_rows<1><<<M, 256, 0, stream>>>(mm, g + D, nullptr, h);
            rms_rows<0><<<M, 256, 0, stream>>>(h, g + 2 * D, hn, nullptr);
            sgemm<2><<<dim3(FF / 128, M / 128), 256, 0, stream>>>(hn, w_up + (size_t)layer * D * FF, tt, M, FF, D);
            sgemm<0><<<dim3(D / 128, M / 128), 256, 0, stream>>>(tt, w_down + (size_t)layer * FF * D, mm, M, D, FF);
            rms_rows<1><<<M, 256, 0, stream>>>(mm, g + 3 * D, nullptr, h);
        }
    }
}
```

```cpp
#include <hip/hip_runtime.h>
#include <hip/hip_cooperative_groups.h>
#include <cstdio>
#include <cstdint>
namespace cg = cooperative_groups;
__device__ __forceinline__ int opaque_lane() { int l = __builtin_amdgcn_mbcnt_hi(~0u, __builtin_amdgcn_mbcnt_lo(~0u, 0u)); asm volatile("" : "+v"(l)); return l; }
template <class T> __device__ __forceinline__ T* opaque_ptr(T* p) { asm volatile("" : "+s"(p)); return p; }
namespace pg8 {
#define PG8_LAS __attribute__((address_space(3)))
typedef unsigned short bf16_t;
typedef short bf16x8 __attribute__((ext_vector_type(8)));
typedef float f32x4 __attribute__((ext_vector_type(4)));
typedef unsigned u32x4 __attribute__((ext_vector_type(4)));
constexpr int BM = 256, BK = 64, HALF = 128, HTB = HALF * BK * 2  , STAGE_BYTES = 8 * HTB, NXCD = 8, WGM = 8;

__host__ __device__ __forceinline__ int lds_byte(int r, int c) { const int st = (r >> 4) * 2 + (c >> 5), rr = r & 15, cc = c & 31, ob = rr * 64 + cc * 2; return st * 1024 + (ob ^ (((ob >> 9) & 1) << 5)); }
__host__ __device__ __forceinline__ void stage_rc(int b, int& R, int& C) { const int st = b / 1024, sb = b % 1024, swz = sb ^ (((sb >> 9) & 1) << 5); R = (st >> 1) * 16 + swz / 64; C = (st & 1) * 32 + (swz % 64) / 2; }
__host__ __device__ __forceinline__ int perm32(int rho) { const int n = rho >> 4, i = rho & 15; return 8 * (i >> 2) + 4 * n + (i & 3); }

struct Unit { int pm, pn; };
struct Gemm { const bf16_t* A; const bf16_t* Bt; int M, N, K; };

struct StaticOrder {
    int nM, nN, nwg, G, c;
    __host__ __device__ void init(int M, int N, int G_, int c_) { nM = M / BM; nN = N / BM; nwg = nM * nN; G = G_; c = c_; }
    __host__ __device__ bool next(int i, Unit& u) const {
        const long L = (long)i * G + c; if (L >= nwg) return false;
        int wgid = (int)L; { const int q = nwg / NXCD, r = nwg % NXCD, xcd = wgid % NXCD, off = wgid / NXCD; wgid = (xcd < r ? xcd * (q + 1) : r * (q + 1) + (xcd - r) * q) + off; }
        const int nig = WGM * nN, gid = wgid / nig, fm = gid * WGM, gsz = (nM - fm) < WGM ? (nM - fm) : WGM;
        u.pm = fm + ((wgid % nig) % gsz); u.pn = (wgid % nig) / gsz; return true;
    }
    __device__ __forceinline__ void a_ready(const Unit&) const {}
    __device__ __forceinline__ void done(const Unit&) const {}
};

__device__ __forceinline__ unsigned cvt_pk_bf16(float lo, float hi) { unsigned r; asm volatile("v_cvt_pk_bf16_f32 %0, %1, %2" : "=v"(r) : "v"(lo), "v"(hi)); return r; }
typedef float f32x2 __attribute__((ext_vector_type(2)));
typedef unsigned u32x2 __attribute__((ext_vector_type(2)));
__device__ __forceinline__ float gelu_tanh_f(float x) {
    const float u = x * (0.7978845608f + 0.0356774081f * x * x);
    const float e = __builtin_amdgcn_exp2f(-2.885390082f * u);
    return x * __builtin_amdgcn_rcpf(1.0f + e);
}
template <int ACT> __device__ __forceinline__ f32x4 act4(f32x4 v) {
    if (ACT == 1) { v[0] = gelu_tanh_f(v[0]); v[1] = gelu_tanh_f(v[1]); v[2] = gelu_tanh_f(v[2]); v[3] = gelu_tanh_f(v[3]); }
    if (ACT == 2) { v[0] = fmaxf(v[0], 0.f); v[1] = fmaxf(v[1], 0.f); v[2] = fmaxf(v[2], 0.f); v[3] = fmaxf(v[3], 0.f); v = v * v; }
    return v;
}
template <int ACT> struct EpiRow {
    static constexpr bool PERM = true, AFTER_DRAIN = false;
    bf16_t* O; bf16_t* O2; int ldc; int split_pn; const float* rs; float scale0;
    __device__ __forceinline__ void operator()(const f32x4 (&acc)[2][2][4][2], const Unit& u, int wr, int wc, int fr, int fq) const {
        const int row0 = u.pm * BM + wr * 64 + fr;
        bf16_t* base = O; int colt = u.pn * BM; float sc = scale0;
        if (u.pn >= split_pn) { base = O2; colt -= split_pn * BM; sc = 1.f; }
        const int col0 = colt + wc * 32 + 8 * fq;
#pragma unroll
        for (int ai = 0; ai < 2; ++ai)
#pragma unroll
            for (int m = 0; m < 4; ++m) {
                const int row = row0 + ai * HALF + m * 16;
                const float r = rs[row] * sc;
                bf16_t* rowp = base + (size_t)row * ldc + col0;
#pragma unroll
                for (int bj = 0; bj < 2; ++bj) {
                    const f32x4 v0 = act4<ACT>(acc[ai][bj][m][0] * r), v1 = act4<ACT>(acc[ai][bj][m][1] * r);
                    u32x4 w; w.x = cvt_pk_bf16(v0[0], v0[1]); w.y = cvt_pk_bf16(v0[2], v0[3]); w.z = cvt_pk_bf16(v1[0], v1[1]); w.w = cvt_pk_bf16(v1[2], v1[3]);
                    *(u32x4*)(rowp + bj * HALF) = w;
                }
            }
    }
};
template <int MODE> struct EpiCol {
    static constexpr bool PERM = true, AFTER_DRAIN = false;
    bf16_t* O; int ldc; const float* cs; float* psum; float* psq;
    __device__ __forceinline__ void operator()(const f32x4 (&acc)[2][2][4][2], const Unit& u, int wr, int wc, int fr, int fq) const {
        const int row0 = u.pm * BM + wr * 64 + fr, col0 = u.pn * BM + wc * 32 + 8 * fq;
        f32x4 sv[2][2], s1[2][2], s2[2][2];
#pragma unroll
        for (int bj = 0; bj < 2; ++bj)
#pragma unroll
            for (int n = 0; n < 2; ++n) { sv[bj][n] = *(const f32x4*)(cs + col0 + bj * HALF + 4 * n); s1[bj][n] = (f32x4){0.f, 0.f, 0.f, 0.f}; s2[bj][n] = (f32x4){0.f, 0.f, 0.f, 0.f}; }
#pragma unroll
        for (int ai = 0; ai < 2; ++ai)
#pragma unroll
            for (int m = 0; m < 4; ++m) {
                bf16_t* rowp = O + (size_t)(row0 + ai * HALF + m * 16) * ldc;
#pragma unroll
                for (int bj = 0; bj < 2; ++bj) {
                    if (MODE == 0) {
                        const f32x4 v0 = act4<1>(acc[ai][bj][m][0] * sv[bj][0]), v1 = act4<1>(acc[ai][bj][m][1] * sv[bj][1]);
                        s1[bj][0] += v0; s2[bj][0] += v0 * v0; s1[bj][1] += v1; s2[bj][1] += v1 * v1;
                        u32x4 w; w.x = cvt_pk_bf16(v0[0], v0[1]); w.y = cvt_pk_bf16(v0[2], v0[3]); w.z = cvt_pk_bf16(v1[0], v1[1]); w.w = cvt_pk_bf16(v1[2], v1[3]);
                        *(u32x4*)(rowp + col0 + bj * HALF) = w;
                    } else {
                        const f32x4 v0 = acc[ai][bj][m][0] * sv[bj][0], v1 = acc[ai][bj][m][1] * sv[bj][1];
                        const int gb = u.pn * BM + bj * HALF + wc * 32 + 16 * (fq >> 1) + 4 * (fq & 1);
                        u32x2 a, b; a.x = cvt_pk_bf16(v0[0], v0[1]); a.y = cvt_pk_bf16(v0[2], v0[3]); b.x = cvt_pk_bf16(v1[0], v1[1]); b.y = cvt_pk_bf16(v1[2], v1[3]);
                        *(u32x2*)(rowp + gb) = a; *(u32x2*)(rowp + gb + 8) = b;
                    }
                }
            }
        if (MODE == 0) {
#pragma unroll
            for (int bj = 0; bj < 2; ++bj)
#pragma unroll
                for (int n = 0; n < 2; ++n) {
#pragma unroll
                    for (int e = 0; e < 4; ++e) {
                        float a = s1[bj][n][e], b = s2[bj][n][e];
                        a += __shfl_xor(a, 1); b += __shfl_xor(b, 1); a += __shfl_xor(a, 2); b += __shfl_xor(b, 2);
                        a += __shfl_xor(a, 4); b += __shfl_xor(b, 4); a += __shfl_xor(a, 8); b += __shfl_xor(b, 8);
                        s1[bj][n][e] = a; s2[bj][n][e] = b;
                    }
                    if (fr == 0) {
                        const size_t po = (size_t)(u.pm * 2 + wr) * ldc + col0 + bj * HALF + 4 * n;
                        *(f32x4*)(psum + po) = s1[bj][n]; *(f32x4*)(psq + po) = s2[bj][n];
                    }
                }
        }
    }
};
struct EpiSq {
    static constexpr bool PERM = true, AFTER_DRAIN = false;
    bf16_t* O; int ldc; float* psq;
    __device__ __forceinline__ void operator()(const f32x4 (&acc)[2][2][4][2], const Unit& u, int wr, int wc, int fr, int fq) const {
        const int row0 = u.pm * BM + wr * 64 + fr, col0 = u.pn * BM + wc * 32 + 8 * fq;
#pragma unroll
        for (int ai = 0; ai < 2; ++ai)
#pragma unroll
            for (int m = 0; m < 4; ++m) {
                const int row = row0 + ai * HALF + m * 16;
                bf16_t* rowp = O + (size_t)row * ldc + col0;
                float s = 0.f;
#pragma unroll
                for (int bj = 0; bj < 2; ++bj) {
                    const f32x4 v0 = acc[ai][bj][m][0], v1 = acc[ai][bj][m][1];
                    s += (v0[0] * v0[0] + v0[1] * v0[1]) + (v0[2] * v0[2] + v0[3] * v0[3]) + (v1[0] * v1[0] + v1[1] * v1[1]) + (v1[2] * v1[2] + v1[3] * v1[3]);
                    u32x4 w; w.x = cvt_pk_bf16(v0[0], v0[1]); w.y = cvt_pk_bf16(v0[2], v0[3]); w.z = cvt_pk_bf16(v1[0], v1[1]); w.w = cvt_pk_bf16(v1[2], v1[3]);
                    *(u32x4*)(rowp + bj * HALF) = w;
                }
                s += __shfl_xor(s, 16); s += __shfl_xor(s, 32);
                if (fq == 0) psq[(size_t)row * 16 + u.pn * 4 + wc] = s;
            }
    }
};
template <class Epi, class Sched, bool ALIGN_EPI = false, bool SP2 = false>
__device__ __forceinline__ void gemm_phase(PG8_LAS unsigned char* lds, const Gemm g, const Sched& S, const Epi& E, const int wid) {
    const int lane = opaque_lane(), tid = wid * 64 + lane, wr = wid >> 2, wc = wid & 3, fr = lane & 15, fq = lane >> 4;
    const int K = g.K, nt = K / BK;
    unsigned voffA[2], voffB[2];
#pragma unroll
    for (int i = 0; i < 2; ++i) { int R, C; stage_rc(tid * 16 + i * 8192, R, C); const int Rb = Epi::PERM ? ((R & ~31) + perm32(R & 31)) : R;
        voffA[i] = (unsigned)(R * K + C) * 2u; voffB[i] = (unsigned)(Rb * K + C) * 2u; }
    const size_t kstep = (size_t)(BK * 2);
    const size_t hstep = (size_t)HALF * K * 2;
    const size_t tstep = 2 * hstep;
    const unsigned ldsw = (unsigned)wid * 1024u;
    const int aoff = lds_byte(wr * 64 + fr, fq * 8), boff = lds_byte(wc * 32 + fr, fq * 8);
#define PG8_SA(b, h) (((b) * 2 + (h)) * HTB)
#define PG8_SB(b, h) ((4 + (b) * 2 + (h)) * HTB)
#define PG8_STAGE(bufoff, gbase, voff) do { _Pragma("unroll") for (int _i = 0; _i < 2; ++_i) \
        __builtin_amdgcn_global_load_lds((const unsigned*)((const char*)(gbase) + (voff)[_i]), (PG8_LAS unsigned*)(lds + (bufoff) + ldsw + _i * 8192), 16, 0, 0); } while (0)
#define PG8_LDA(dst, b, h) do { _Pragma("unroll") for (int m = 0; m < 4; ++m) _Pragma("unroll") for (int k = 0; k < 2; ++k) dst[m][k] = *(const PG8_LAS bf16x8*)(lds + PG8_SA(b, h) + aoff + m * 2048 + k * 1024); } while (0)
#define PG8_LDB(dst, b, h) do { _Pragma("unroll") for (int n = 0; n < 2; ++n) _Pragma("unroll") for (int k = 0; k < 2; ++k) dst[n][k] = *(const PG8_LAS bf16x8*)(lds + PG8_SB(b, h) + boff + n * 2048 + k * 1024); } while (0)
#define PG8_MMA(ai, bj, At, Bt) do { __builtin_amdgcn_s_setprio(1); _Pragma("unroll") for (int m = 0; m < 4; ++m) _Pragma("unroll") for (int n = 0; n < 2; ++n) _Pragma("unroll") for (int k = 0; k < 2; ++k) \
        acc[ai][bj][m][n] = __builtin_amdgcn_mfma_f32_16x16x32_bf16(Bt[n][k], At[m][k], acc[ai][bj][m][n], 0, 0, 0); __builtin_amdgcn_s_setprio(0); } while (0)
#define PG8_WAIT_V(n) asm volatile("s_waitcnt vmcnt(" #n ")" ::: "memory")
#define PG8_WAIT_L(n) asm volatile("s_waitcnt lgkmcnt(" #n ")" ::: "memory")
#define PG8_BAR __builtin_amdgcn_s_barrier()
#define PG8_SCHED __builtin_amdgcn_sched_barrier(0)
    Unit cur, nxt; int ui = 0;
    if (!S.next(0, cur)) return;
    f32x4 acc[2][2][4][2];
#pragma unroll
    for (int a = 0; a < 2; ++a)
#pragma unroll
        for (int b = 0; b < 2; ++b)
#pragma unroll
            for (int m = 0; m < 4; ++m)
#pragma unroll
                for (int n = 0; n < 2; ++n) acc[a][b][m][n] = (f32x4){0.f, 0.f, 0.f, 0.f};
    bf16x8 At[4][2], B0[2][2], B1[2][2];
    const char* cA = (const char*)g.A + (size_t)cur.pm * tstep; const char* cB = (const char*)g.Bt + (size_t)cur.pn * tstep;
    S.a_ready(cur);
    if constexpr (SP2) {
        PG8_STAGE(PG8_SB(0, 0), cB, voffB); PG8_STAGE(PG8_SB(0, 1), cB + hstep, voffB); PG8_STAGE(PG8_SA(0, 0), cA, voffA); PG8_STAGE(PG8_SA(0, 1), cA + hstep, voffA);
        if (wr == 1) PG8_BAR;
        PG8_WAIT_V(2); PG8_BAR;
        PG8_STAGE(PG8_SB(1, 0), cB + kstep, voffB); PG8_STAGE(PG8_SA(1, 0), cA + kstep, voffA); PG8_STAGE(PG8_SB(1, 1), cB + hstep + kstep, voffB);
        PG8_WAIT_V(6); PG8_BAR;
    } else {
        PG8_STAGE(PG8_SB(0, 0), cB, voffB); PG8_STAGE(PG8_SA(0, 0), cA, voffA); PG8_STAGE(PG8_SB(0, 1), cB + hstep, voffB); PG8_STAGE(PG8_SA(0, 1), cA + hstep, voffA);
        if (wr == 1) PG8_BAR;
        PG8_WAIT_V(4); PG8_BAR;
        PG8_STAGE(PG8_SB(1, 0), cB + kstep, voffB); PG8_STAGE(PG8_SA(1, 0), cA + kstep, voffA); PG8_STAGE(PG8_SB(1, 1), cB + hstep + kstep, voffB);
        PG8_WAIT_V(6); PG8_BAR;
    }
    for (;;) {
        const bool has_next = S.next(ui + 1, nxt);
        const char* nA = has_next ? (const char*)g.A + (size_t)nxt.pm * tstep : cA; const char* nB = has_next ? (const char*)g.Bt + (size_t)nxt.pn * tstep : cB;
        for (int t = 0; t < nt; t += 2) {
            const bool last = (t == nt - 2);
            const char* a1 = cA + (size_t)(t + 1) * kstep;
            const char* a2 = last ? nA : cA + (size_t)(t + 2) * kstep; const char* b2 = last ? nB : cB + (size_t)(t + 2) * kstep;
            const char* a3 = a2 + kstep; const char* b3 = b2 + kstep;
            if (last && has_next) S.a_ready(nxt);
            if constexpr (SP2) {
            PG8_LDB(B0, 0, 0); PG8_LDB(B1, 0, 1); PG8_SCHED; PG8_LDA(At, 0, 0); PG8_STAGE(PG8_SA(1, 1), a1 + hstep, voffA);
            PG8_WAIT_V(8); PG8_WAIT_L(0); PG8_BAR; PG8_MMA(0, 0, At, B0); PG8_MMA(0, 1, At, B1); PG8_BAR; PG8_SCHED;
            PG8_LDA(At, 0, 1); PG8_STAGE(PG8_SB(0, 0), b2, voffB); PG8_STAGE(PG8_SB(0, 1), b2 + hstep, voffB); PG8_STAGE(PG8_SA(0, 0), a2, voffA);
            PG8_WAIT_V(8); PG8_WAIT_L(0); PG8_BAR; PG8_MMA(1, 0, At, B0); PG8_MMA(1, 1, At, B1); PG8_BAR; PG8_SCHED;
            PG8_LDB(B0, 1, 0); PG8_LDB(B1, 1, 1); PG8_SCHED; PG8_LDA(At, 1, 0); PG8_STAGE(PG8_SA(0, 1), a2 + hstep, voffA);
            PG8_WAIT_V(8); PG8_WAIT_L(0); PG8_BAR; PG8_MMA(0, 0, At, B0); PG8_MMA(0, 1, At, B1); PG8_BAR; PG8_SCHED;
            PG8_LDA(At, 1, 1); PG8_STAGE(PG8_SB(1, 0), b3, voffB); PG8_STAGE(PG8_SB(1, 1), b3 + hstep, voffB); PG8_STAGE(PG8_SA(1, 0), a3, voffA);
            PG8_WAIT_V(8); PG8_WAIT_L(0); PG8_BAR; PG8_MMA(1, 0, At, B0); PG8_MMA(1, 1, At, B1); PG8_BAR; PG8_SCHED;
            } else {
            PG8_LDB(B0, 0, 0); PG8_SCHED; PG8_LDA(At, 0, 0); PG8_STAGE(PG8_SA(1, 1), a1 + hstep, voffA);
            PG8_WAIT_L(8); PG8_BAR; PG8_WAIT_L(0); PG8_MMA(0, 0, At, B0); PG8_BAR; PG8_SCHED;
            PG8_LDB(B1, 0, 1); PG8_STAGE(PG8_SB(0, 0), b2, voffB);
            PG8_BAR; PG8_WAIT_L(0); PG8_MMA(0, 1, At, B1); PG8_BAR;
            PG8_LDA(At, 0, 1); PG8_STAGE(PG8_SA(0, 0), a2, voffA);
            PG8_BAR; PG8_WAIT_L(0); PG8_MMA(1, 0, At, B0); PG8_BAR; PG8_SCHED;
            PG8_STAGE(PG8_SB(0, 1), b2 + hstep, voffB);
            PG8_WAIT_V(6); PG8_BAR; PG8_MMA(1, 1, At, B1); PG8_BAR;
            PG8_LDB(B0, 1, 0); PG8_SCHED; PG8_LDA(At, 1, 0); PG8_STAGE(PG8_SA(0, 1), a2 + hstep, voffA);
            PG8_WAIT_L(8); PG8_BAR; PG8_WAIT_L(0); PG8_MMA(0, 0, At, B0); PG8_BAR; PG8_SCHED;
            PG8_LDB(B1, 1, 1); PG8_STAGE(PG8_SB(1, 0), b3, voffB);
            PG8_BAR; PG8_WAIT_L(0); PG8_MMA(0, 1, At, B1); PG8_BAR;
            PG8_LDA(At, 1, 1); PG8_STAGE(PG8_SA(1, 0), a3, voffA);
            PG8_BAR; PG8_WAIT_L(0); PG8_MMA(1, 0, At, B0); PG8_BAR; PG8_SCHED;
            PG8_STAGE(PG8_SB(1, 1), b3 + hstep, voffB);
            PG8_WAIT_V(6); PG8_BAR; PG8_MMA(1, 1, At, B1); PG8_BAR;
            }
        }
        if constexpr (ALIGN_EPI) { if (wr == 0) PG8_BAR; }
        if constexpr (!Epi::AFTER_DRAIN) { E(acc, cur, wr, wc, fr, fq); S.done(cur); }
        if (!has_next) break;
#pragma unroll
        for (int a = 0; a < 2; ++a)
#pragma unroll
            for (int b = 0; b < 2; ++b)
#pragma unroll
                for (int m = 0; m < 4; ++m)
#pragma unroll
                    for (int n = 0; n < 2; ++n) acc[a][b][m][n] = (f32x4){0.f, 0.f, 0.f, 0.f};
        cur = nxt; cA = nA; cB = nB; ++ui;
        if constexpr (ALIGN_EPI) { if (wr == 1) PG8_BAR; }
    }
    PG8_WAIT_V(0);
    if constexpr (!ALIGN_EPI) { if (wr == 0) PG8_BAR; }
    PG8_BAR;
    if constexpr (Epi::AFTER_DRAIN) { E.fused(acc, cur, wr, wc, fr, fq, lds, wid, lane); S.done(cur); }
#undef PG8_SA
#undef PG8_SB
#undef PG8_STAGE
#undef PG8_LDA
#undef PG8_LDB
#undef PG8_MMA
#undef PG8_WAIT_V
#undef PG8_WAIT_L
#undef PG8_BAR
#undef PG8_SCHED
}
}

#define LAS __attribute__((address_space(3)))
typedef unsigned short bf16_t;
typedef float f32x4 __attribute__((ext_vector_type(4)));
typedef float f32x16 __attribute__((ext_vector_type(16)));
typedef unsigned u32x4 __attribute__((ext_vector_type(4)));
typedef unsigned u32x2 __attribute__((ext_vector_type(2)));
typedef short bf16x8 __attribute__((ext_vector_type(8)));
constexpr int D = 1024, SEQ = 4096, NBATCH = 4, M = NBATCH * SEQ, FF = 4096, NH = 16;
constexpr size_t MiB = 1u << 20;
constexpr size_t WS_RSTD = 0, WS_PSQ = 1 * MiB, WS_LNS = 2 * MiB, WS_LNQ = 2 * MiB + 512 * 1024;
constexpr size_t WS_WA = 4 * MiB, WS_WB = 10 * MiB, WS_WUP = 12 * MiB, WS_WDN = 20 * MiB;
constexpr size_t WS_HB = 28 * MiB, WS_T = 60 * MiB, WS_U = 60 * MiB, WS_VT = 92 * MiB, WS_UG = 124 * MiB, WS_Q = 60 * MiB, WS_O = 92 * MiB;
constexpr size_t WS_K = 188 * MiB, WS_VTA = 220 * MiB, WS_END = 252 * MiB;
constexpr int LDS_BYTES = 147456;
constexpr float LOG2E = 1.4426950408889634f;
constexpr float QSCALE = 0.125f * LOG2E;

__device__ __forceinline__ float wave_sum(float v) {
#pragma unroll
    for (int o = 1; o < 64; o <<= 1) v += __shfl_xor(v, o);
    return v;
}
__device__ __forceinline__ unsigned pk2(float lo, float hi) { return pg8::cvt_pk_bf16(lo, hi); }
__device__ __forceinline__ float bflo(unsigned w) { return __uint_as_float(w << 16); }
__device__ __forceinline__ float bfhi(unsigned w) { return __uint_as_float(w & 0xffff0000u); }

__device__ __forceinline__ void transpose_item(const float* W, const float* gain, int K, int N, bf16_t* WT, LAS float* scr, int item, int lane) {
    const int nblk = N / 32, kb = item / nblk, nb = item % nblk, k0 = 64 * kb, n0 = 32 * nb;
#pragma unroll 8
    for (int i = 0; i < 32; ++i) { const int kk = 2 * i + (lane >> 5); float w = W[(size_t)(k0 + kk) * N + n0 + (lane & 31)]; if (gain) w *= gain[k0 + kk]; scr[kk * 33 + (lane & 31)] = w; }
    asm volatile("s_waitcnt lgkmcnt(0)" ::: "memory");
    const int c = lane & 7;
#pragma unroll
    for (int j = 0; j < 4; ++j) { const int n = (lane >> 3) + 8 * j; const LAS float* s = scr + (8 * c) * 33 + n;
        u32x4 o; o.x = pk2(s[0 * 33], s[1 * 33]); o.y = pk2(s[2 * 33], s[3 * 33]); o.z = pk2(s[4 * 33], s[5 * 33]); o.w = pk2(s[6 * 33], s[7 * 33]);
        *(u32x4*)(WT + (size_t)(n0 + n) * K + k0 + 8 * c) = o; }
    asm volatile("s_waitcnt lgkmcnt(0)" ::: "memory");
}
__device__ __forceinline__ void convert_job(const float* W, const float* gain, int K, int N, bf16_t* WT, int off, LAS float* scr, int gw, int NGW, int lane) {
    const int nitems = (K / 64) * (N / 32);
    int it0 = gw - off; if (it0 < 0) it0 += NGW;
    for (int it = it0; it < nitems; it += NGW) transpose_item(W, gain, K, N, WT, scr, it, lane);
}

struct Params {
    const float *x, *norm_g, *a_w_in, *a_ln_g, *a_ln_b, *a_w_s, *a_b_s, *a_w_out, *kv_norm_g, *w_k, *w_v, *b_w_q, *b_rel, *b_w_o, *w_up, *w_down;
    float* out; unsigned char* ws;
};

__device__ __forceinline__ void convert_layer(const Params& P, int layer, LAS float* scr, int gw, int NGW, int lane) {
    unsigned char* ws = opaque_ptr(P.ws);
    const float* g = P.norm_g + (size_t)layer * 4 * D;
    const int q1 = NGW / 4;
    if (layer < 2) {
        convert_job(P.a_w_in + (size_t)layer * D * 2048, g, D, 2048, (bf16_t*)(ws + WS_WA), 0, scr, gw, NGW, lane);
        convert_job(P.a_w_out + (size_t)layer * D * D, nullptr, D, D, (bf16_t*)(ws + WS_WB), 2 * q1, scr, gw, NGW, lane);
    } else {
        const int j = layer - 2;
        convert_job(P.b_w_q + (size_t)j * D * D, g, D, D, (bf16_t*)(ws + WS_WA), 0, scr, gw, NGW, lane);
        if (layer == 2) {
            convert_job(P.w_k, P.kv_norm_g, D, D, (bf16_t*)(ws + WS_WA) + (size_t)D * D, q1, scr, gw, NGW, lane);
            convert_job(P.w_v, P.kv_norm_g, D, D, (bf16_t*)(ws + WS_WA) + (size_t)2 * D * D, 2 * q1, scr, gw, NGW, lane);
        }
        convert_job(P.b_w_o + (size_t)j * D * D, nullptr, D, D, (bf16_t*)(ws + WS_WB), 3 * q1, scr, gw, NGW, lane);
    }
    convert_job(P.w_up + (size_t)layer * D * FF, g + 2 * D, D, FF, (bf16_t*)(ws + WS_WUP), 0, scr, gw, NGW, lane);
    convert_job(P.w_down + (size_t)layer * FF * D, nullptr, FF, D, (bf16_t*)(ws + WS_WDN), 0, scr, gw, NGW, lane);
}

__device__ __forceinline__ void rowpass0(int gw, int NGW, int lane, const float* x, bf16_t* hb, float* rstd) {
    for (int row = gw; row < M; row += NGW) {
        f32x4 hv[4]; float s = 0.f;
#pragma unroll
        for (int j = 0; j < 4; ++j) { hv[j] = *(const f32x4*)(x + (size_t)row * D + 4 * lane + 256 * j); s += (hv[j][0] * hv[j][0] + hv[j][1] * hv[j][1]) + (hv[j][2] * hv[j][2] + hv[j][3] * hv[j][3]); }
        const float rh = 1.0f / sqrtf(wave_sum(s) * (1.0f / D) + 1e-6f);
        if (lane == 0) rstd[row] = rh;
#pragma unroll
        for (int j = 0; j < 4; ++j) { u32x2 w; w.x = pk2(hv[j][0], hv[j][1]); w.y = pk2(hv[j][2], hv[j][3]); *(u32x2*)(hb + (size_t)row * D + 4 * lane + 256 * j) = w; }
    }
}
__device__ __forceinline__ void rowpass(int gw, int NGW, int lane, const float* hin, float* hout, bf16_t* hbm, const float* psq, const float* g, float* rstd) {
    for (int row = gw; row < M; row += NGW) {
        const float mq = lane < 16 ? psq[(size_t)row * 16 + lane] : 0.f;
        u32x2 mr[4]; f32x4 hv[4], gv[4];
#pragma unroll
        for (int j = 0; j < 4; ++j) { const size_t o = (size_t)row * D + 4 * lane + 256 * j; mr[j] = *(const u32x2*)(hbm + o); hv[j] = *(const f32x4*)(hin + o); gv[j] = *(const f32x4*)(g + 4 * lane + 256 * j); }
        const float rm = 1.0f / sqrtf(wave_sum(mq) * (1.0f / D) + 1e-6f);
        float s = 0.f;
#pragma unroll
        for (int j = 0; j < 4; ++j) {
            f32x4 mv; mv[0] = bflo(mr[j].x); mv[1] = bfhi(mr[j].x); mv[2] = bflo(mr[j].y); mv[3] = bfhi(mr[j].y);
            hv[j] = hv[j] + mv * rm * gv[j];
            s += (hv[j][0] * hv[j][0] + hv[j][1] * hv[j][1]) + (hv[j][2] * hv[j][2] + hv[j][3] * hv[j][3]);
            *(f32x4*)(hout + (size_t)row * D + 4 * lane + 256 * j) = hv[j];
        }
        const float rh = 1.0f / sqrtf(wave_sum(s) * (1.0f / D) + 1e-6f);
        if (lane == 0) rstd[row] = rh;
#pragma unroll
        for (int j = 0; j < 4; ++j) { u32x2 w; w.x = pk2(hv[j][0], hv[j][1]); w.y = pk2(hv[j][2], hv[j][3]); *(u32x2*)(hbm + (size_t)row * D + 4 * lane + 256 * j) = w; }
    }
}

__device__ __forceinline__ void gate_phase(LAS unsigned char* lds, int vcu, int G, const bf16_t* U, const bf16_t* VT, const float* psum, const float* psq,
                                           const float* lng, const float* lnb, const float* wsp, const float* bsp, bf16_t* UG, const int wave) {
    const int lane = opaque_lane(), tid = wave * 64 + lane, fr = lane & 15, fq = lane >> 4;
    LAS bf16_t* tile = (LAS bf16_t*)lds;
    LAS float* st = (LAS float*)(lds + 36864);
    for (int unit = vcu; unit < 1024; unit += G) {
        const int nb = unit >> 3, g = unit & 7, tok0 = nb * 128;
        __syncthreads();
        if (tid < 128) {
            float s = 0.f, q = 0.f;
#pragma unroll
            for (int p = 0; p < 8; ++p) { s += psum[(size_t)p * M + tok0 + tid]; q += psq[(size_t)p * M + tok0 + tid]; }
            const float mu = s * (1.0f / 1024), var = q * (1.0f / 1024) - mu * mu;
            st[2 * tid] = mu; st[2 * tid + 1] = 1.0f / sqrtf(fmaxf(var, 0.f) + 1e-5f);
        }
        __syncthreads();
#pragma unroll
        for (int r = 0; r < 4; ++r) {
            const int q = tid + 512 * r, d = q >> 4, jc = q & 15;
            const u32x4 raw = *(const u32x4*)(VT + (size_t)(g * 128 + d) * M + tok0 + 8 * jc);
            const float lg = lng[g * 128 + d], lb = lnb[g * 128 + d];
            const f32x4 s0 = *(const LAS f32x4*)(st + 16 * jc), s1 = *(const LAS f32x4*)(st + 16 * jc + 4), s2 = *(const LAS f32x4*)(st + 16 * jc + 8), s3 = *(const LAS f32x4*)(st + 16 * jc + 12);
            u32x4 o;
            o.x = pk2((bflo(raw.x) - s0[0]) * s0[1] * lg + lb, (bfhi(raw.x) - s0[2]) * s0[3] * lg + lb);
            o.y = pk2((bflo(raw.y) - s1[0]) * s1[1] * lg + lb, (bfhi(raw.y) - s1[2]) * s1[3] * lg + lb);
            o.z = pk2((bflo(raw.z) - s2[0]) * s2[1] * lg + lb, (bfhi(raw.z) - s2[2]) * s2[3] * lg + lb);
            o.w = pk2((bflo(raw.w) - s3[0]) * s3[1] * lg + lb, (bfhi(raw.w) - s3[2]) * s3[3] * lg + lb);
            *(LAS u32x4*)(tile + d * 136 + 8 * jc) = o;
        }
        __syncthreads();
        const int i0 = 16 * wave, nk = wave < 4 ? 2 : 4;
        bf16x8 wm[4];
#pragma unroll
        for (int ks = 0; ks < 4; ++ks) {
            u32x4 w = (u32x4){0u, 0u, 0u, 0u};
            if (ks < nk) { const float* wp = wsp + ((size_t)g * 128 + i0 + fr) * 128 + 32 * ks + 8 * fq; const f32x4 a = *(const f32x4*)wp, b = *(const f32x4*)(wp + 4);
                w.x = pk2(a[0], a[1]); w.y = pk2(a[2], a[3]); w.z = pk2(b[0], b[1]); w.w = pk2(b[2], b[3]); }
            wm[ks] = __builtin_bit_cast(bf16x8, w);
        }
        const float bias = bsp[g * 128 + i0 + fr];
#pragma unroll
        for (int dt = 0; dt < 8; ++dt) {
            f32x4 acc = (f32x4){0.f, 0.f, 0.f, 0.f};
#pragma unroll
            for (int ks = 0; ks < 4; ++ks) if (ks < nk) {
                const bf16x8 a = *(const LAS bf16x8*)(tile + (16 * dt + fr) * 136 + 32 * ks + 8 * fq);
                acc = __builtin_amdgcn_mfma_f32_16x16x32_bf16(a, wm[ks], acc, 0, 0, 0);
            }
            const size_t off = (size_t)(tok0 + i0 + fr) * D + g * 128 + 16 * dt + 4 * fq;
            const u32x2 uu = *(const u32x2*)(U + off);
            u32x2 o; o.x = pk2(bflo(uu.x) * (acc[0] + bias), bfhi(uu.x) * (acc[1] + bias)); o.y = pk2(bflo(uu.y) * (acc[2] + bias), bfhi(uu.y) * (acc[3] + bias));
            *(u32x2*)(UG + off) = o;
        }
    }
}

__device__ __forceinline__ int crow(int r, int hi) { return (r & 3) + 8 * (r >> 2) + 4 * hi; }
__device__ __forceinline__ bf16x8 ldg16(const bf16_t* base, unsigned byte_off) { return *(const bf16x8*)((const char*)base + byte_off); }
__device__ __forceinline__ void attn_phase(LAS unsigned char* lds, int vcu, int G, const bf16_t* Q, const bf16_t* K, const bf16_t* VTp, const float* tblg, bf16_t* O, const int wave) {
    const int lane = opaque_lane(), tid = wave * 64 + lane, r32 = lane & 31, hi = lane >> 5;
    LAS float* tb = (LAS float*)lds;
    __syncthreads();
    for (int i = tid; i < NH * 513; i += 512) { const int h = i / 513, j = i - h * 513; tb[h * 516 + j] = tblg[i] * LOG2E; }
    __syncthreads();
    const int gw = vcu * 8 + wave, NGW = G * 8;
    const unsigned rowoff = (unsigned)(r32 * D + 8 * hi) * 2u;
    const unsigned voff = (unsigned)r32 * (unsigned)(M * 2) + 16u * hi;
    for (int idx = gw; idx < NBATCH * 64 * NH; idx += NGW) {
        const int h = idx & 15, c = (idx >> 4) & 63, b = idx >> 10;
        const int tok0 = b * SEQ + c * 64;
        const bf16_t* Qu = Q + (size_t)tok0 * D + h * 64;
        bf16x8 qf[2][4];
#pragma unroll
        for (int qh = 0; qh < 2; ++qh)
#pragma unroll
            for (int d0 = 0; d0 < 4; ++d0) qf[qh][d0] = ldg16(Qu + (size_t)qh * 32 * D + 16 * d0, rowoff);
        f32x16 o[2][2];
#pragma unroll
        for (int a = 0; a < 2; ++a)
#pragma unroll
            for (int e = 0; e < 2; ++e)
#pragma unroll
                for (int r = 0; r < 16; ++r) o[a][e][r] = 0.f;
        float mref[2] = {-1e30f, -1e30f}, lsum[2] = {0.f, 0.f};
        const LAS float* tbh = tb + h * 516;
        const int kc0 = c > 8 ? c - 8 : 0;
        const int nsteps = 2 * (c - kc0 + 1);
        const int ktok0 = b * SEQ + kc0 * 64;
        const bf16_t* Ku = K + (size_t)ktok0 * D + h * 64;
        const bf16_t* Vu = VTp + (size_t)(h * 64) * M + ktok0;
        bf16x8 kf[4];
#pragma unroll
        for (int d0 = 0; d0 < 4; ++d0) kf[d0] = ldg16(Ku + 16 * d0, rowoff);
#pragma unroll 1
        for (int st = 0; st < nsteps; ++st) {
            bf16x8 vf[2][2];
#pragma unroll
            for (int e = 0; e < 2; ++e)
#pragma unroll
                for (int s2 = 0; s2 < 2; ++s2) vf[e][s2] = ldg16(Vu + (size_t)(32 * e) * M + 32 * st + 16 * s2, voff);
            f32x16 p[2];
#pragma unroll
            for (int qh = 0; qh < 2; ++qh) {
                f32x16 acc;
#pragma unroll
                for (int r = 0; r < 16; ++r) acc[r] = 0.f;
#pragma unroll
                for (int d0 = 0; d0 < 4; ++d0) acc = __builtin_amdgcn_mfma_f32_32x32x16_bf16(kf[d0], qf[qh][d0], acc, 0, 0, 0);
                p[qh] = acc;
            }
            if (st + 1 < nsteps) {
#pragma unroll
                for (int d0 = 0; d0 < 4; ++d0) kf[d0] = ldg16(Ku + (size_t)(32 * (st + 1)) * D + 16 * d0, rowoff);
            }
            const int dc = c - kc0 - (st >> 1), kh = st & 1;
            if (dc >= 5) {
                const float bc = tbh[512];
#pragma unroll
                for (int qh = 0; qh < 2; ++qh)
#pragma unroll
                    for (int r = 0; r < 16; ++r) p[qh][r] += bc;
            } else {
                const int dbase = 64 * dc - 32 * kh + r32 - 4 * hi + 256;
#pragma unroll
                for (int qh = 0; qh < 2; ++qh)
#pragma unroll
                    for (int r = 0; r < 16; ++r) {
                        int di = dbase + 32 * qh - ((r & 3) + 8 * (r >> 2));
                        di = di > 512 ? 512 : di;
                        p[qh][r] += tbh[di];
                    }
            }
            bf16x8 pb[2][2];
#pragma unroll
            for (int qh = 0; qh < 2; ++qh) {
                float mt = p[qh][0];
#pragma unroll
                for (int r = 1; r < 16; ++r) mt = fmaxf(mt, p[qh][r]);
                mt = fmaxf(mt, __shfl_xor(mt, 32));
                const float mn = fmaxf(mref[qh], mt), f = __builtin_amdgcn_exp2f(mref[qh] - mn);
                mref[qh] = mn; lsum[qh] *= f;
#pragma unroll
                for (int e = 0; e < 2; ++e)
#pragma unroll
                    for (int r = 0; r < 16; ++r) o[qh][e][r] *= f;
                float sm = 0.f;
#pragma unroll
                for (int r = 0; r < 16; ++r) { const float pe = __builtin_amdgcn_exp2f(p[qh][r] - mn); p[qh][r] = pe; sm += pe; }
                lsum[qh] += sm;
#pragma unroll
                for (int s2 = 0; s2 < 2; ++s2) {
                    const int r0 = 8 * s2;
                    u32x4 w; w.x = pk2(p[qh][r0 + 0], p[qh][r0 + 1]); w.y = pk2(p[qh][r0 + 2], p[qh][r0 + 3]); w.z = pk2(p[qh][r0 + 4], p[qh][r0 + 5]); w.w = pk2(p[qh][r0 + 6], p[qh][r0 + 7]);
                    pb[qh][s2] = __builtin_bit_cast(bf16x8, w);
                }
            }
#pragma unroll
            for (int e = 0; e < 2; ++e)
#pragma unroll
                for (int s2 = 0; s2 < 2; ++s2)
#pragma unroll
                    for (int qh = 0; qh < 2; ++qh) o[qh][e] = __builtin_amdgcn_mfma_f32_32x32x16_bf16(vf[e][s2], pb[qh][s2], o[qh][e], 0, 0, 0);
        }
#pragma unroll
        for (int qh = 0; qh < 2; ++qh) {
            const float lt = lsum[qh] + __shfl_xor(lsum[qh], 32), inv = 1.0f / lt;
            char* op = (char*)(O + (size_t)(tok0 + 32 * qh) * D + h * 64) + (unsigned)(r32 * D + 4 * hi) * 2u;
#pragma unroll
            for (int e = 0; e < 2; ++e)
#pragma unroll
                for (int a = 0; a < 4; ++a) {
                    u32x2 w; w.x = pk2(o[qh][e][4 * a + 0] * inv, o[qh][e][4 * a + 1] * inv); w.y = pk2(o[qh][e][4 * a + 2] * inv, o[qh][e][4 * a + 3] * inv);
                    *(u32x2*)(op + (32 * e + 8 * a) * 2) = w;
                }
        }
    }
}

#define WSB(off) (opaque_ptr(P.ws) + (off))
__global__ void __launch_bounds__(512, 2) mega_fwd(Params P) {
    extern __shared__ __attribute__((aligned(16))) unsigned char lds_raw[];
    LAS unsigned char* lds = (LAS unsigned char*)lds_raw;
    const int wave = __builtin_amdgcn_readfirstlane((int)threadIdx.x >> 6);
    const int G = gridDim.x, bx = blockIdx.x;
    const int vcu = (G % 8 == 0) ? (bx % 8) * (G / 8) + bx / 8 : bx;
    const int gw = vcu * 8 + wave, NGW = G * 8;
    LAS float* scr = (LAS float*)(lds + wave * 16384);

    convert_layer(P, 0, scr, gw, NGW, opaque_lane());
    rowpass0(gw, NGW, opaque_lane(), P.x, (bf16_t*)WSB(WS_HB), (float*)WSB(WS_RSTD));
    cg::this_grid().sync();

#pragma unroll 1
    for (int layer = 0; layer < 4; ++layer) {
        const float* g = P.norm_g + (size_t)layer * 4 * D;
        if (layer < 2) {
            {
                unsigned char* ws = WSB(0);
                pg8::Gemm gm{(bf16_t*)(ws + WS_HB), (bf16_t*)(ws + WS_WA), M, D, D}; pg8::StaticOrder S; S.init(M, D, G, bx);
                pg8::EpiRow<1> E{(bf16_t*)(ws + WS_U), nullptr, D, 1 << 20, (float*)(ws + WS_RSTD), 1.0f};
                pg8::gemm_phase<pg8::EpiRow<1>, pg8::StaticOrder, true, true>(lds, gm, S, E, wave);
            }
            {
                unsigned char* ws = WSB(0);
                pg8::Gemm gm{(bf16_t*)(ws + WS_WA) + (size_t)D * D, (bf16_t*)(ws + WS_HB), D, M, D}; pg8::StaticOrder S; S.init(D, M, G, bx);
                pg8::EpiCol<0> E{(bf16_t*)(ws + WS_VT), M, (float*)(ws + WS_RSTD), (float*)(ws + WS_LNS), (float*)(ws + WS_LNQ)};
                pg8::gemm_phase<pg8::EpiCol<0>, pg8::StaticOrder, true, true>(lds, gm, S, E, wave);
            }
        } else {
            {
                unsigned char* ws = WSB(0);
                const int N = layer == 2 ? 2 * D : D;
                pg8::Gemm gm{(bf16_t*)(ws + WS_HB), (bf16_t*)(ws + WS_WA), M, N, D}; pg8::StaticOrder S; S.init(M, N, G, bx);
                pg8::EpiRow<0> E{(bf16_t*)(ws + WS_Q), (bf16_t*)(ws + WS_K), D, 4, (float*)(ws + WS_RSTD), QSCALE};
                pg8::gemm_phase<pg8::EpiRow<0>, pg8::StaticOrder, true, true>(lds, gm, S, E, wave);
            }
            if (layer == 2) {
                unsigned char* ws = WSB(0);
                pg8::Gemm gm{(bf16_t*)(ws + WS_WA) + (size_t)2 * D * D, (bf16_t*)(ws + WS_HB), D, M, D}; pg8::StaticOrder S; S.init(D, M, G, bx);
                pg8::EpiCol<1> E{(bf16_t*)(ws + WS_VTA), M, (float*)(ws + WS_RSTD), nullptr, nullptr};
                pg8::gemm_phase<pg8::EpiCol<1>, pg8::StaticOrder, true, true>(lds, gm, S, E, wave);
            }
        }
        cg::this_grid().sync();
        if (layer < 2) {
            unsigned char* ws = WSB(0);
            gate_phase(lds, vcu, G, (const bf16_t*)(ws + WS_U), (const bf16_t*)(ws + WS_VT), (const float*)(ws + WS_LNS), (const float*)(ws + WS_LNQ), P.a_ln_g + layer * D, P.a_ln_b + layer * D,
                       P.a_w_s + (size_t)layer * 8 * 128 * 128, P.a_b_s + layer * 8 * 128, (bf16_t*)(ws + WS_UG), wave);
        } else {
            unsigned char* ws = WSB(0);
            attn_phase(lds, vcu, G, (const bf16_t*)(ws + WS_Q), (const bf16_t*)(ws + WS_K), (const bf16_t*)(ws + WS_VTA), P.b_rel + (size_t)(layer - 2) * NH * 513, (bf16_t*)(ws + WS_O), wave);
        }
        cg::this_grid().sync();
        {
            unsigned char* ws = WSB(0);
            pg8::Gemm gm{layer < 2 ? (const bf16_t*)(ws + WS_UG) : (const bf16_t*)(ws + WS_O), (bf16_t*)(ws + WS_WB), M, D, D}; pg8::StaticOrder S; S.init(M, D, G, bx);
            pg8::EpiSq E{(bf16_t*)(ws + WS_HB), D, (float*)(ws + WS_PSQ)};
            pg8::gemm_phase<pg8::EpiSq, pg8::StaticOrder, true, true>(lds, gm, S, E, wave);
        }
        cg::this_grid().sync();
        { unsigned char* ws = WSB(0); rowpass(gw, NGW, opaque_lane(), layer == 0 ? P.x : P.out, P.out, (bf16_t*)(ws + WS_HB), (const float*)(ws + WS_PSQ), g + D, (float*)(ws + WS_RSTD)); }
        cg::this_grid().sync();
        {
            unsigned char* ws = WSB(0);
            pg8::Gemm gm{(bf16_t*)(ws + WS_HB), (bf16_t*)(ws + WS_WUP), M, FF, D}; pg8::StaticOrder S; S.init(M, FF, G, bx);
            pg8::EpiRow<2> E{(bf16_t*)(ws + WS_T), nullptr, FF, 1 << 20, (float*)(ws + WS_RSTD), 1.0f};
            pg8::gemm_phase<pg8::EpiRow<2>, pg8::StaticOrder, true, true>(lds, gm, S, E, wave);
        }
        cg::this_grid().sync();
        {
            unsigned char* ws = WSB(0);
            pg8::Gemm gm{(bf16_t*)(ws + WS_T), (bf16_t*)(ws + WS_WDN), M, D, FF}; pg8::StaticOrder S; S.init(M, D, G, bx);
            pg8::EpiSq E{(bf16_t*)(ws + WS_HB), D, (float*)(ws + WS_PSQ)};
            pg8::gemm_phase<pg8::EpiSq, pg8::StaticOrder, true, true>(lds, gm, S, E, wave);
        }
        cg::this_grid().sync();
        { unsigned char* ws = WSB(0); rowpass(gw, NGW, opaque_lane(), P.out, P.out, (bf16_t*)(ws + WS_HB), (const float*)(ws + WS_PSQ), g + 3 * D, (float*)(ws + WS_RSTD)); }
        if (layer < 3) { convert_layer(P, layer + 1, scr, gw, NGW, opaque_lane()); cg::this_grid().sync(); }
    }
}

extern "C" void kernel_launch(void* const* d_in, const int* in_sizes, int n_in, void* d_out, int out_size, void* d_ws, size_t ws_size, hipStream_t stream) {
    static int grid = 0;
    if (grid == 0) {
        if (n_in != 16 || out_size != M * D || ws_size < WS_END) { fprintf(stderr, "kernel_launch: unexpected shapes: n_in %d out %d ws %zu\n", n_in, out_size, ws_size); grid = -1; return; }
        int dev = 0, cus = 0, per_cu = 0;
        if (hipGetDevice(&dev) != hipSuccess || hipDeviceGetAttribute(&cus, hipDeviceAttributeMultiprocessorCount, dev) != hipSuccess) { grid = -1; return; }
        if (hipFuncSetAttribute((const void*)mega_fwd, hipFuncAttributeMaxDynamicSharedMemorySize, LDS_BYTES) != hipSuccess) { fprintf(stderr, "kernel_launch: hipFuncSetAttribute failed\n"); grid = -1; return; }
        if (hipOccupancyMaxActiveBlocksPerMultiprocessor(&per_cu, (const void*)mega_fwd, 512, LDS_BYTES) != hipSuccess || per_cu < 1) { fprintf(stderr, "kernel_launch: occupancy query failed (%d)\n", per_cu); grid = -1; return; }
        grid = cus * per_cu;
        fprintf(stderr, "kernel_launch: grid %d (%d CUs x %d)\n", grid, cus, per_cu);
    }
    if (grid < 0) return;
    Params p{};
    p.x = (const float*)d_in[0]; p.norm_g = (const float*)d_in[1]; p.a_w_in = (const float*)d_in[2]; p.a_ln_g = (const float*)d_in[3]; p.a_ln_b = (const float*)d_in[4];
    p.a_w_s = (const float*)d_in[5]; p.a_b_s = (const float*)d_in[6]; p.a_w_out = (const float*)d_in[7]; p.kv_norm_g = (const float*)d_in[8]; p.w_k = (const float*)d_in[9];
    p.w_v = (const float*)d_in[10]; p.b_w_q = (const float*)d_in[11]; p.b_rel = (const float*)d_in[12]; p.b_w_o = (const float*)d_in[13]; p.w_up = (const float*)d_in[14]; p.w_down = (const float*)d_in[15];
    p.out = (float*)d_out; p.ws = (unsigned char*)d_ws;
    void* args[] = {&p};
    const hipError_t e = hipLaunchCooperativeKernel((const void*)mega_fwd, dim3(grid), dim3(512), args, LDS_BYTES, stream);
    if (e != hipSuccess) fprintf(stderr, "kernel_launch: cooperative launch failed: %s (grid %d)\n", hipGetErrorString(e), grid);
}
```

```cpp
#include <hip/hip_runtime.h>
#include <hip/hip_cooperative_groups.h>
#include <cstdio>
#include <cstdint>
namespace cg = cooperative_groups;
__device__ __forceinline__ int opaque_lane() { int l = __builtin_amdgcn_mbcnt_hi(~0u, __builtin_amdgcn_mbcnt_lo(~0u, 0u)); asm volatile("" : "+v"(l)); return l; }
template <class T> __device__ __forceinline__ T* opaque_ptr(T* p) { asm volatile("" : "+s"(p)); return p; }
namespace pg8 {
#define PG8_LAS __attribute__((address_space(3)))
typedef unsigned short bf16_t;
typedef short bf16x8 __attribute__((ext_vector_type(8)));
typedef float f32x4 __attribute__((ext_vector_type(4)));
typedef unsigned u32x4 __attribute__((ext_vector_type(4)));
constexpr int BM = 256, BK = 64, HALF = 128, HTB = HALF * BK * 2  , STAGE_BYTES = 8 * HTB, NXCD = 8, WGM = 8;

__host__ __device__ __forceinline__ int lds_byte(int r, int c) { const int st = (r >> 4) * 2 + (c >> 5), rr = r & 15, cc = c & 31, ob = rr * 64 + cc * 2; return st * 1024 + (ob ^ (((ob >> 9) & 1) << 5)); }
__host__ __device__ __forceinline__ void stage_rc(int b, int& R, int& C) { const int st = b / 1024, sb = b % 1024, swz = sb ^ (((sb >> 9) & 1) << 5); R = (st >> 1) * 16 + swz / 64; C = (st & 1) * 32 + (swz % 64) / 2; }
__host__ __device__ __forceinline__ int perm32(int rho) { const int n = rho >> 4, i = rho & 15; return 8 * (i >> 2) + 4 * n + (i & 3); }

struct Unit { int pm, pn; };
struct Gemm { const bf16_t* A; const bf16_t* Bt; int M, N, K; };

struct StaticOrder {
    int nM, nN, nwg, G, c;
    __host__ __device__ void init(int M, int N, int G_, int c_) { nM = M / BM; nN = N / BM; nwg = nM * nN; G = G_; c = c_; }
    __host__ __device__ bool next(int i, Unit& u) const {
        const long L = (long)i * G + c; if (L >= nwg) return false;
        int wgid = (int)L; { const int q = nwg / NXCD, r = nwg % NXCD, xcd = wgid % NXCD, off = wgid / NXCD; wgid = (xcd < r ? xcd * (q + 1) : r * (q + 1) + (xcd - r) * q) + off; }
        const int nig = WGM * nN, gid = wgid / nig, fm = gid * WGM, gsz = (nM - fm) < WGM ? (nM - fm) : WGM;
        u.pm = fm + ((wgid % nig) % gsz); u.pn = (wgid % nig) / gsz; return true;
    }
    __device__ __forceinline__ void a_ready(const Unit&) const {}
    __device__ __forceinline__ void done(const Unit&) const {}
};

__device__ __forceinline__ unsigned cvt_pk_bf16(float lo, float hi) { unsigned r; asm volatile("v_cvt_pk_bf16_f32 %0, %1, %2" : "=v"(r) : "v"(lo), "v"(hi)); return r; }
typedef float f32x2 __attribute__((ext_vector_type(2)));
typedef unsigned u32x2 __attribute__((ext_vector_type(2)));
__device__ __forceinline__ float gelu_tanh_f(float x) {
    const float u = x * (0.7978845608f + 0.0356774081f * x * x);
    const float e = __builtin_amdgcn_exp2f(-2.885390082f * u);
    return x * __builtin_amdgcn_rcpf(1.0f + e);
}
template <int ACT> __device__ __forceinline__ f32x4 act4(f32x4 v) {
    if (ACT == 1) { v[0] = gelu_tanh_f(v[0]); v[1] = gelu_tanh_f(v[1]); v[2] = gelu_tanh_f(v[2]); v[3] = gelu_tanh_f(v[3]); }
    if (ACT == 2) { v[0] = fmaxf(v[0], 0.f); v[1] = fmaxf(v[1], 0.f); v[2] = fmaxf(v[2], 0.f); v[3] = fmaxf(v[3], 0.f); v = v * v; }
    return v;
}
template <int ACT> struct EpiRow {
    static constexpr bool PERM = true, AFTER_DRAIN = false;
    bf16_t* O; bf16_t* O2; int ldc; int split_pn; const float* rs; float scale0;
    __device__ __forceinline__ void operator()(const f32x4 (&acc)[2][2][4][2], const Unit& u, int wr, int wc, int fr, int fq) const {
        const int row0 = u.pm * BM + wr * 64 + fr;
        bf16_t* base = O; int colt = u.pn * BM; float sc = scale0;
        if (u.pn >= split_pn) { base = O2; colt -= split_pn * BM; sc = 1.f; }
        const int col0 = colt + wc * 32 + 8 * fq;
#pragma unroll
        for (int ai = 0; ai < 2; ++ai)
#pragma unroll
            for (int m = 0; m < 4; ++m) {
                const int row = row0 + ai * HALF + m * 16;
                const float r = rs[row] * sc;
                bf16_t* rowp = base + (size_t)row * ldc + col0;
#pragma unroll
                for (int bj = 0; bj < 2; ++bj) {
                    const f32x4 v0 = act4<ACT>(acc[ai][bj][m][0] * r), v1 = act4<ACT>(acc[ai][bj][m][1] * r);
                    u32x4 w; w.x = cvt_pk_bf16(v0[0], v0[1]); w.y = cvt_pk_bf16(v0[2], v0[3]); w.z = cvt_pk_bf16(v1[0], v1[1]); w.w = cvt_pk_bf16(v1[2], v1[3]);
                    *(u32x4*)(rowp + bj * HALF) = w;
                }
            }
    }
};
template <int MODE> struct EpiCol {
    static constexpr bool PERM = true, AFTER_DRAIN = false;
    bf16_t* O; int ldc; const float* cs; float* psum; float* psq;
    __device__ __forceinline__ void operator()(const f32x4 (&acc)[2][2][4][2], const Unit& u, int wr, int wc, int fr, int fq) const {
        const int row0 = u.pm * BM + wr * 64 + fr, col0 = u.pn * BM + wc * 32 + 8 * fq;
        f32x4 sv[2][2], s1[2][2], s2[2][2];
#pragma unroll
        for (int bj = 0; bj < 2; ++bj)
#pragma unroll
            for (int n = 0; n < 2; ++n) { sv[bj][n] = *(const f32x4*)(cs + col0 + bj * HALF + 4 * n); s1[bj][n] = (f32x4){0.f, 0.f, 0.f, 0.f}; s2[bj][n] = (f32x4){0.f, 0.f, 0.f, 0.f}; }
#pragma unroll
        for (int ai = 0; ai < 2; ++ai)
#pragma unroll
            for (int m = 0; m < 4; ++m) {
                bf16_t* rowp = O + (size_t)(row0 + ai * HALF + m * 16) * ldc;
#pragma unroll
                for (int bj = 0; bj < 2; ++bj) {
                    if (MODE == 0) {
                        const f32x4 v0 = act4<1>(acc[ai][bj][m][0] * sv[bj][0]), v1 = act4<1>(acc[ai][bj][m][1] * sv[bj][1]);
                        s1[bj][0] += v0; s2[bj][0] += v0 * v0; s1[bj][1] += v1; s2[bj][1] += v1 * v1;
                        u32x4 w; w.x = cvt_pk_bf16(v0[0], v0[1]); w.y = cvt_pk_bf16(v0[2], v0[3]); w.z = cvt_pk_bf16(v1[0], v1[1]); w.w = cvt_pk_bf16(v1[2], v1[3]);
                        *(u32x4*)(rowp + col0 + bj * HALF) = w;
                    } else {
                        const f32x4 v0 = acc[ai][bj][m][0] * sv[bj][0], v1 = acc[ai][bj][m][1] * sv[bj][1];
                        const int gb = u.pn * BM + bj * HALF + wc * 32 + 16 * (fq >> 1) + 4 * (fq & 1);
                        u32x2 a, b; a.x = cvt_pk_bf16(v0[0], v0[1]); a.y = cvt_pk_bf16(v0[2], v0[3]); b.x = cvt_pk_bf16(v1[0], v1[1]); b.y = cvt_pk_bf16(v1[2], v1[3]);
                        *(u32x2*)(rowp + gb) = a; *(u32x2*)(rowp + gb + 8) = b;
                    }
                }
            }
        if (MODE == 0) {
#pragma unroll
            for (int bj = 0; bj < 2; ++bj)
#pragma unroll
                for (int n = 0; n < 2; ++n) {
#pragma unroll
                    for (int e = 0; e < 4; ++e) {
                        float a = s1[bj][n][e], b = s2[bj][n][e];
                        a += __shfl_xor(a, 1); b += __shfl_xor(b, 1); a += __shfl_xor(a, 2); b += __shfl_xor(b, 2);
                        a += __shfl_xor(a, 4); b += __shfl_xor(b, 4); a += __shfl_xor(a, 8); b += __shfl_xor(b, 8);
                        s1[bj][n][e] = a; s2[bj][n][e] = b;
                    }
                    if (fr == 0) {
                        const size_t po = (size_t)(u.pm * 2 + wr) * ldc + col0 + bj * HALF + 4 * n;
                        *(f32x4*)(psum + po) = s1[bj][n]; *(f32x4*)(psq + po) = s2[bj][n];
                    }
                }
        }
    }
};
struct EpiSq {
    static constexpr bool PERM = true, AFTER_DRAIN = false;
    bf16_t* O; int ldc; float* psq;
    __device__ __forceinline__ void operator()(const f32x4 (&acc)[2][2][4][2], const Unit& u, int wr, int wc, int fr, int fq) const {
        const int row0 = u.pm * BM + wr * 64 + fr, col0 = u.pn * BM + wc * 32 + 8 * fq;
#pragma unroll
        for (int ai = 0; ai < 2; ++ai)
#pragma unroll
            for (int m = 0; m < 4; ++m) {
                const int row = row0 + ai * HALF + m * 16;
                bf16_t* rowp = O + (size_t)row * ldc + col0;
                float s = 0.f;
#pragma unroll
                for (int bj = 0; bj < 2; ++bj) {
                    const f32x4 v0 = acc[ai][bj][m][0], v1 = acc[ai][bj][m][1];
                    s += (v0[0] * v0[0] + v0[1] * v0[1]) + (v0[2] * v0[2] + v0[3] * v0[3]) + (v1[0] * v1[0] + v1[1] * v1[1]) + (v1[2] * v1[2] + v1[3] * v1[3]);
                    u32x4 w; w.x = cvt_pk_bf16(v0[0], v0[1]); w.y = cvt_pk_bf16(v0[2], v0[3]); w.z = cvt_pk_bf16(v1[0], v1[1]); w.w = cvt_pk_bf16(v1[2], v1[3]);
                    *(u32x4*)(rowp + bj * HALF) = w;
                }
                s += __shfl_xor(s, 16); s += __shfl_xor(s, 32);
                if (fq == 0) psq[(size_t)row * 16 + u.pn * 4 + wc] = s;
            }
    }
};
template <class Epi, class Sched, bool ALIGN_EPI = false, bool SP2 = false>
__device__ __forceinline__ void gemm_phase(PG8_LAS unsigned char* lds, const Gemm g, const Sched& S, const Epi& E, const int wid) {
    const int lane = opaque_lane(), tid = wid * 64 + lane, wr = wid >> 2, wc = wid & 3, fr = lane & 15, fq = lane >> 4;
    const int K = g.K, nt = K / BK;
    unsigned voffA[2], voffB[2];
#pragma unroll
    for (int i = 0; i < 2; ++i) { int R, C; stage_rc(tid * 16 + i * 8192, R, C); const int Rb = Epi::PERM ? ((R & ~31) + perm32(R & 31)) : R;
        voffA[i] = (unsigned)(R * K + C) * 2u; voffB[i] = (unsigned)(Rb * K + C) * 2u; }
    const size_t kstep = (size_t)(BK * 2);
    const size_t hstep = (size_t)HALF * K * 2;
    const size_t tstep = 2 * hstep;
    const unsigned ldsw = (unsigned)wid * 1024u;
    const int aoff = lds_byte(wr * 64 + fr, fq * 8), boff = lds_byte(wc * 32 + fr, fq * 8);
#define PG8_SA(b, h) (((b) * 2 + (h)) * HTB)
#define PG8_SB(b, h) ((4 + (b) * 2 + (h)) * HTB)
#define PG8_STAGE(bufoff, gbase, voff) do { _Pragma("unroll") for (int _i = 0; _i < 2; ++_i) \
        __builtin_amdgcn_global_load_lds((const unsigned*)((const char*)(gbase) + (voff)[_i]), (PG8_LAS unsigned*)(lds + (bufoff) + ldsw + _i * 8192), 16, 0, 0); } while (0)
#define PG8_LDA(dst, b, h) do { _Pragma("unroll") for (int m = 0; m < 4; ++m) _Pragma("unroll") for (int k = 0; k < 2; ++k) dst[m][k] = *(const PG8_LAS bf16x8*)(lds + PG8_SA(b, h) + aoff + m * 2048 + k * 1024); } while (0)
#define PG8_LDB(dst, b, h) do { _Pragma("unroll") for (int n = 0; n < 2; ++n) _Pragma("unroll") for (int k = 0; k < 2; ++k) dst[n][k] = *(const PG8_LAS bf16x8*)(lds + PG8_SB(b, h) + boff + n * 2048 + k * 1024); } while (0)
#define PG8_MMA(ai, bj, At, Bt) do { __builtin_amdgcn_s_setprio(1); _Pragma("unroll") for (int m = 0; m < 4; ++m) _Pragma("unroll") for (int n = 0; n < 2; ++n) _Pragma("unroll") for (int k = 0; k < 2; ++k) \
        acc[ai][bj][m][n] = __builtin_amdgcn_mfma_f32_16x16x32_bf16(Bt[n][k], At[m][k], acc[ai][bj][m][n], 0, 0, 0); __builtin_amdgcn_s_setprio(0); } while (0)
#define PG8_WAIT_V(n) asm volatile("s_waitcnt vmcnt(" #n ")" ::: "memory")
#define PG8_WAIT_L(n) asm volatile("s_waitcnt lgkmcnt(" #n ")" ::: "memory")
#define PG8_BAR __builtin_amdgcn_s_barrier()
#define PG8_SCHED __builtin_amdgcn_sched_barrier(0)
    Unit cur, nxt; int ui = 0;
    if (!S.next(0, cur)) return;
    f32x4 acc[2][2][4][2];
#pragma unroll
    for (int a = 0; a < 2; ++a)
#pragma unroll
        for (int b = 0; b < 2; ++b)
#pragma unroll
            for (int m = 0; m < 4; ++m)
#pragma unroll
                for (int n = 0; n < 2; ++n) acc[a][b][m][n] = (f32x4){0.f, 0.f, 0.f, 0.f};
    bf16x8 At[4][2], B0[2][2], B1[2][2];
    const char* cA = (const char*)g.A + (size_t)cur.pm * tstep; const char* cB = (const char*)g.Bt + (size_t)cur.pn * tstep;
    S.a_ready(cur);
    if constexpr (SP2) {
        PG8_STAGE(PG8_SB(0, 0), cB, voffB); PG8_STAGE(PG8_SB(0, 1), cB + hstep, voffB); PG8_STAGE(PG8_SA(0, 0), cA, voffA); PG8_STAGE(PG8_SA(0, 1), cA + hstep, voffA);
        if (wr == 1) PG8_BAR;
        PG8_WAIT_V(2); PG8_BAR;
        PG8_STAGE(PG8_SB(1, 0), cB + kstep, voffB); PG8_STAGE(PG8_SA(1, 0), cA + kstep, voffA); PG8_STAGE(PG8_SB(1, 1), cB + hstep + kstep, voffB);
        PG8_WAIT_V(6); PG8_BAR;
    } else {
        PG8_STAGE(PG8_SB(0, 0), cB, voffB); PG8_STAGE(PG8_SA(0, 0), cA, voffA); PG8_STAGE(PG8_SB(0, 1), cB + hstep, voffB); PG8_STAGE(PG8_SA(0, 1), cA + hstep, voffA);
        if (wr == 1) PG8_BAR;
        PG8_WAIT_V(4); PG8_BAR;
        PG8_STAGE(PG8_SB(1, 0), cB + kstep, voffB); PG8_STAGE(PG8_SA(1, 0), cA + kstep, voffA); PG8_STAGE(PG8_SB(1, 1), cB + hstep + kstep, voffB);
        PG8_WAIT_V(6); PG8_BAR;
    }
    for (;;) {
        const bool has_next = S.next(ui + 1, nxt);
        const char* nA = has_next ? (const char*)g.A + (size_t)nxt.pm * tstep : cA; const char* nB = has_next ? (const char*)g.Bt + (size_t)nxt.pn * tstep : cB;
        for (int t = 0; t < nt; t += 2) {
            const bool last = (t == nt - 2);
            const char* a1 = cA + (size_t)(t + 1) * kstep;
            const char* a2 = last ? nA : cA + (size_t)(t + 2) * kstep; const char* b2 = last ? nB : cB + (size_t)(t + 2) * kstep;
            const char* a3 = a2 + kstep; const char* b3 = b2 + kstep;
            if (last && has_next) S.a_ready(nxt);
            if constexpr (SP2) {
            PG8_LDB(B0, 0, 0); PG8_LDB(B1, 0, 1); PG8_SCHED; PG8_LDA(At, 0, 0); PG8_STAGE(PG8_SA(1, 1), a1 + hstep, voffA);
            PG8_WAIT_V(8); PG8_WAIT_L(0); PG8_BAR; PG8_MMA(0, 0, At, B0); PG8_MMA(0, 1, At, B1); PG8_BAR; PG8_SCHED;
            PG8_LDA(At, 0, 1); PG8_STAGE(PG8_SB(0, 0), b2, voffB); PG8_STAGE(PG8_SB(0, 1), b2 + hstep, voffB); PG8_STAGE(PG8_SA(0, 0), a2, voffA);
            PG8_WAIT_V(8); PG8_WAIT_L(0); PG8_BAR; PG8_MMA(1, 0, At, B0); PG8_MMA(1, 1, At, B1); PG8_BAR; PG8_SCHED;
            PG8_LDB(B0, 1, 0); PG8_LDB(B1, 1, 1); PG8_SCHED; PG8_LDA(At, 1, 0); PG8_STAGE(PG8_SA(0, 1), a2 + hstep, voffA);
            PG8_WAIT_V(8); PG8_WAIT_L(0); PG8_BAR; PG8_MMA(0, 0, At, B0); PG8_MMA(0, 1, At, B1); PG8_BAR; PG8_SCHED;
            PG8_LDA(At, 1, 1); PG8_STAGE(PG8_SB(1, 0), b3, voffB); PG8_STAGE(PG8_SB(1, 1), b3 + hstep, voffB); PG8_STAGE(PG8_SA(1, 0), a3, voffA);
            PG8_WAIT_V(8); PG8_WAIT_L(0); PG8_BAR; PG8_MMA(1, 0, At, B0); PG8_MMA(1, 1, At, B1); PG8_BAR; PG8_SCHED;
            } else {
            PG8_LDB(B0, 0, 0); PG8_SCHED; PG8_LDA(At, 0, 0); PG8_STAGE(PG8_SA(1, 1), a1 + hstep, voffA);
            PG8_WAIT_L(8); PG8_BAR; PG8_WAIT_L(0); PG8_MMA(0, 0, At, B0); PG8_BAR; PG8_SCHED;
            PG8_LDB(B1, 0, 1); PG8_STAGE(PG8_SB(0, 0), b2, voffB);
            PG8_BAR; PG8_WAIT_L(0); PG8_MMA(0, 1, At, B1); PG8_BAR;
            PG8_LDA(At, 0, 1); PG8_STAGE(PG8_SA(0, 0), a2, voffA);
            PG8_BAR; PG8_WAIT_L(0); PG8_MMA(1, 0, At, B0); PG8_BAR; PG8_SCHED;
            PG8_STAGE(PG8_SB(0, 1), b2 + hstep, voffB);
            PG8_WAIT_V(6); PG8_BAR; PG8_MMA(1, 1, At, B1); PG8_BAR;
            PG8_LDB(B0, 1, 0); PG8_SCHED; PG8_LDA(At, 1, 0); PG8_STAGE(PG8_SA(0, 1), a2 + hstep, voffA);
            PG8_WAIT_L(8); PG8_BAR; PG8_WAIT_L(0); PG8_MMA(0, 0, At, B0); PG8_BAR; PG8_SCHED;
            PG8_LDB(B1, 1, 1); PG8_STAGE(PG8_SB(1, 0), b3, voffB);
            PG8_BAR; PG8_WAIT_L(0); PG8_MMA(0, 1, At, B1); PG8_BAR;
            PG8_LDA(At, 1, 1); PG8_STAGE(PG8_SA(1, 0), a3, voffA);
            PG8_BAR; PG8_WAIT_L(0); PG8_MMA(1, 0, At, B0); PG8_BAR; PG8_SCHED;
            PG8_STAGE(PG8_SB(1, 1), b3 + hstep, voffB);
            PG8_WAIT_V(6); PG8_BAR; PG8_MMA(1, 1, At, B1); PG8_BAR;
            }
        }
        if constexpr (ALIGN_EPI) { if (wr == 0) PG8_BAR; }
        if constexpr (!Epi::AFTER_DRAIN) { E(acc, cur, wr, wc, fr, fq); S.done(cur); }
        if (!has_next) break;
#pragma unroll
        for (int a = 0; a < 2; ++a)
#pragma unroll
            for (int b = 0; b < 2; ++b)
#pragma unroll
                for (int m = 0; m < 4; ++m)
#pragma unroll
                    for (int n = 0; n < 2; ++n) acc[a][b][m][n] = (f32x4){0.f, 0.f, 0.f, 0.f};
        cur = nxt; cA = nA; cB = nB; ++ui;
        if constexpr (ALIGN_EPI) { if (wr == 1) PG8_BAR; }
    }
    PG8_WAIT_V(0);
    if constexpr (!ALIGN_EPI) { if (wr == 0) PG8_BAR; }
    PG8_BAR;
    if constexpr (Epi::AFTER_DRAIN) { E.fused(acc, cur, wr, wc, fr, fq, lds, wid, lane); S.done(cur); }
#undef PG8_SA
#undef PG8_SB
#undef PG8_STAGE
#undef PG8_LDA
#undef PG8_LDB
#undef PG8_MMA
#undef PG8_WAIT_V
#undef PG8_WAIT_L
#undef PG8_BAR
#undef PG8_SCHED
}
}

#define LAS __attribute__((address_space(3)))
typedef unsigned short bf16_t;
typedef float f32x4 __attribute__((ext_vector_type(4)));
typedef float f32x16 __attribute__((ext_vector_type(16)));
typedef unsigned u32x4 __attribute__((ext_vector_type(4)));
typedef unsigned u32x2 __attribute__((ext_vector_type(2)));
typedef short bf16x8 __attribute__((ext_vector_type(8)));
constexpr int D = 1024, SEQ = 4096, NBATCH = 4, M = NBATCH * SEQ, FF = 4096, NH = 16;
constexpr size_t MiB = 1u << 20;
constexpr size_t WS_RSTD = 0, WS_PSQ = 1 * MiB, WS_LNS = 2 * MiB, WS_LNQ = 2 * MiB + 512 * 1024;
constexpr size_t WS_WA = 4 * MiB, WS_WB = 10 * MiB, WS_WUP = 12 * MiB, WS_WDN = 20 * MiB;
constexpr size_t WS_HB = 28 * MiB, WS_T = 60 * MiB, WS_U = 60 * MiB, WS_VT = 92 * MiB, WS_UG = 124 * MiB, WS_Q = 60 * MiB, WS_O = 92 * MiB;
constexpr size_t WS_K = 188 * MiB, WS_VTA = 220 * MiB, WS_END = 252 * MiB;
constexpr size_t WS_BAR = 3 * MiB, BAR_ZERO_BYTES = 16384;
constexpr int LDS_BYTES = 147456, LDS_MISC = 131072 + 512;
constexpr float LOG2E = 1.4426950408889634f;
constexpr float QSCALE = 0.125f * LOG2E;

__device__ __forceinline__ float wave_sum(float v) {
#pragma unroll
    for (int o = 1; o < 64; o <<= 1) v += __shfl_xor(v, o);
    return v;
}
__device__ __forceinline__ unsigned pk2(float lo, float hi) { return pg8::cvt_pk_bf16(lo, hi); }
__device__ __forceinline__ float bflo(unsigned w) { return __uint_as_float(w << 16); }
__device__ __forceinline__ float bfhi(unsigned w) { return __uint_as_float(w & 0xffff0000u); }

__device__ __forceinline__ void transpose_item(const float* W, const float* gain, int K, int N, bf16_t* WT, LAS float* scr, int item, int lane) {
    const int nblk = N / 32, kb = item / nblk, nb = item % nblk, k0 = 64 * kb, n0 = 32 * nb;
#pragma unroll 8
    for (int i = 0; i < 32; ++i) { const int kk = 2 * i + (lane >> 5); float w = W[(size_t)(k0 + kk) * N + n0 + (lane & 31)]; if (gain) w *= gain[k0 + kk]; scr[kk * 33 + (lane & 31)] = w; }
    asm volatile("s_waitcnt lgkmcnt(0)" ::: "memory");
    const int c = lane & 7;
#pragma unroll
    for (int j = 0; j < 4; ++j) { const int n = (lane >> 3) + 8 * j; const LAS float* s = scr + (8 * c) * 33 + n;
        u32x4 o; o.x = pk2(s[0 * 33], s[1 * 33]); o.y = pk2(s[2 * 33], s[3 * 33]); o.z = pk2(s[4 * 33], s[5 * 33]); o.w = pk2(s[6 * 33], s[7 * 33]);
        *(u32x4*)(WT + (size_t)(n0 + n) * K + k0 + 8 * c) = o; }
    asm volatile("s_waitcnt lgkmcnt(0)" ::: "memory");
}
__device__ __forceinline__ void convert_job(const float* W, const float* gain, int K, int N, bf16_t* WT, int off, LAS float* scr, int gw, int NGW, int lane) {
    const int nitems = (K / 64) * (N / 32);
    int it0 = gw - off; if (it0 < 0) it0 += NGW;
    for (int it = it0; it < nitems; it += NGW) transpose_item(W, gain, K, N, WT, scr, it, lane);
}

struct Params {
    const float *x, *norm_g, *a_w_in, *a_ln_g, *a_ln_b, *a_w_s, *a_b_s, *a_w_out, *kv_norm_g, *w_k, *w_v, *b_w_q, *b_rel, *b_w_o, *w_up, *w_down;
    float* out; unsigned char* ws;
};

__device__ __forceinline__ void convert_layer(const Params& P, int layer, LAS float* scr, int gw, int NGW, int lane) {
    unsigned char* ws = opaque_ptr(P.ws);
    const float* g = P.norm_g + (size_t)layer * 4 * D;
    const int q1 = NGW / 4;
    if (layer < 2) {
        convert_job(P.a_w_in + (size_t)layer * D * 2048, g, D, 2048, (bf16_t*)(ws + WS_WA), 0, scr, gw, NGW, lane);
        convert_job(P.a_w_out + (size_t)layer * D * D, nullptr, D, D, (bf16_t*)(ws + WS_WB), 2 * q1, scr, gw, NGW, lane);
    } else {
        const int j = layer - 2;
        convert_job(P.b_w_q + (size_t)j * D * D, g, D, D, (bf16_t*)(ws + WS_WA), 0, scr, gw, NGW, lane);
        if (layer == 2) {
            convert_job(P.w_k, P.kv_norm_g, D, D, (bf16_t*)(ws + WS_WA) + (size_t)D * D, q1, scr, gw, NGW, lane);
            convert_job(P.w_v, P.kv_norm_g, D, D, (bf16_t*)(ws + WS_WA) + (size_t)2 * D * D, 2 * q1, scr, gw, NGW, lane);
        }
        convert_job(P.b_w_o + (size_t)j * D * D, nullptr, D, D, (bf16_t*)(ws + WS_WB), 3 * q1, scr, gw, NGW, lane);
    }
    convert_job(P.w_up + (size_t)layer * D * FF, g + 2 * D, D, FF, (bf16_t*)(ws + WS_WUP), 0, scr, gw, NGW, lane);
    convert_job(P.w_down + (size_t)layer * FF * D, nullptr, FF, D, (bf16_t*)(ws + WS_WDN), 0, scr, gw, NGW, lane);
}

__device__ __forceinline__ void rowpass0(int gw, int NGW, int lane, const float* x, bf16_t* hb, float* rstd) {
    for (int row = gw; row < M; row += NGW) {
        f32x4 hv[4]; float s = 0.f;
#pragma unroll
        for (int j = 0; j < 4; ++j) { hv[j] = *(const f32x4*)(x + (size_t)row * D + 4 * lane + 256 * j); s += (hv[j][0] * hv[j][0] + hv[j][1] * hv[j][1]) + (hv[j][2] * hv[j][2] + hv[j][3] * hv[j][3]); }
        const float rh = 1.0f / sqrtf(wave_sum(s) * (1.0f / D) + 1e-6f);
        if (lane == 0) rstd[row] = rh;
#pragma unroll
        for (int j = 0; j < 4; ++j) { u32x2 w; w.x = pk2(hv[j][0], hv[j][1]); w.y = pk2(hv[j][2], hv[j][3]); *(u32x2*)(hb + (size_t)row * D + 4 * lane + 256 * j) = w; }
    }
}
__device__ __forceinline__ void rowpass(int gw, int NGW, int lane, const float* hin, float* hout, bf16_t* hbm, const float* psq, const float* g, float* rstd) {
    for (int row = gw; row < M; row += NGW) {
        const float mq = lane < 16 ? psq[(size_t)row * 16 + lane] : 0.f;
        u32x2 mr[4]; f32x4 hv[4], gv[4];
#pragma unroll
        for (int j = 0; j < 4; ++j) { const size_t o = (size_t)row * D + 4 * lane + 256 * j; mr[j] = *(const u32x2*)(hbm + o); hv[j] = *(const f32x4*)(hin + o); gv[j] = *(const f32x4*)(g + 4 * lane + 256 * j); }
        const float rm = 1.0f / sqrtf(wave_sum(mq) * (1.0f / D) + 1e-6f);
        float s = 0.f;
#pragma unroll
        for (int j = 0; j < 4; ++j) {
            f32x4 mv; mv[0] = bflo(mr[j].x); mv[1] = bfhi(mr[j].x); mv[2] = bflo(mr[j].y); mv[3] = bfhi(mr[j].y);
            hv[j] = hv[j] + mv * rm * gv[j];
            s += (hv[j][0] * hv[j][0] + hv[j][1] * hv[j][1]) + (hv[j][2] * hv[j][2] + hv[j][3] * hv[j][3]);
            *(f32x4*)(hout + (size_t)row * D + 4 * lane + 256 * j) = hv[j];
        }
        const float rh = 1.0f / sqrtf(wave_sum(s) * (1.0f / D) + 1e-6f);
        if (lane == 0) rstd[row] = rh;
#pragma unroll
        for (int j = 0; j < 4; ++j) { u32x2 w; w.x = pk2(hv[j][0], hv[j][1]); w.y = pk2(hv[j][2], hv[j][3]); *(u32x2*)(hbm + (size_t)row * D + 4 * lane + 256 * j) = w; }
    }
}

__device__ __forceinline__ void gate_phase(LAS unsigned char* lds, int vcu, int G, const bf16_t* U, const bf16_t* VT, const float* psum, const float* psq,
                                           const float* lng, const float* lnb, const float* wsp, const float* bsp, bf16_t* UG, const int wave) {
    const int lane = opaque_lane(), tid = wave * 64 + lane, fr = lane & 15, fq = lane >> 4;
    LAS bf16_t* tile = (LAS bf16_t*)lds;
    LAS float* st = (LAS float*)(lds + 36864);
    for (int unit = vcu; unit < 1024; unit += G) {
        const int nb = unit >> 3, g = unit & 7, tok0 = nb * 128;
        __syncthreads();
        if (tid < 128) {
            float s = 0.f, q = 0.f;
#pragma unroll
            for (int p = 0; p < 8; ++p) { s += psum[(size_t)p * M + tok0 + tid]; q += psq[(size_t)p * M + tok0 + tid]; }
            const float mu = s * (1.0f / 1024), var = q * (1.0f / 1024) - mu * mu;
            st[2 * tid] = mu; st[2 * tid + 1] = 1.0f / sqrtf(fmaxf(var, 0.f) + 1e-5f);
        }
        __syncthreads();
#pragma unroll
        for (int r = 0; r < 4; ++r) {
            const int q = tid + 512 * r, d = q >> 4, jc = q & 15;
            const u32x4 raw = *(const u32x4*)(VT + (size_t)(g * 128 + d) * M + tok0 + 8 * jc);
            const float lg = lng[g * 128 + d], lb = lnb[g * 128 + d];
            const f32x4 s0 = *(const LAS f32x4*)(st + 16 * jc), s1 = *(const LAS f32x4*)(st + 16 * jc + 4), s2 = *(const LAS f32x4*)(st + 16 * jc + 8), s3 = *(const LAS f32x4*)(st + 16 * jc + 12);
            u32x4 o;
            o.x = pk2((bflo(raw.x) - s0[0]) * s0[1] * lg + lb, (bfhi(raw.x) - s0[2]) * s0[3] * lg + lb);
            o.y = pk2((bflo(raw.y) - s1[0]) * s1[1] * lg + lb, (bfhi(raw.y) - s1[2]) * s1[3] * lg + lb);
            o.z = pk2((bflo(raw.z) - s2[0]) * s2[1] * lg + lb, (bfhi(raw.z) - s2[2]) * s2[3] * lg + lb);
            o.w = pk2((bflo(raw.w) - s3[0]) * s3[1] * lg + lb, (bfhi(raw.w) - s3[2]) * s3[3] * lg + lb);
            *(LAS u32x4*)(tile + d * 136 + 8 * jc) = o;
        }
        __syncthreads();
        const int i0 = 16 * wave, nk = wave < 4 ? 2 : 4;
        bf16x8 wm[4];
#pragma unroll
        for (int ks = 0; ks < 4; ++ks) {
            u32x4 w = (u32x4){0u, 0u, 0u, 0u};
            if (ks < nk) { const float* wp = wsp + ((size_t)g * 128 + i0 + fr) * 128 + 32 * ks + 8 * fq; const f32x4 a = *(const f32x4*)wp, b = *(const f32x4*)(wp + 4);
                w.x = pk2(a[0], a[1]); w.y = pk2(a[2], a[3]); w.z = pk2(b[0], b[1]); w.w = pk2(b[2], b[3]); }
            wm[ks] = __builtin_bit_cast(bf16x8, w);
        }
        const float bias = bsp[g * 128 + i0 + fr];
#pragma unroll
        for (int dt = 0; dt < 8; ++dt) {
            f32x4 acc = (f32x4){0.f, 0.f, 0.f, 0.f};
#pragma unroll
            for (int ks = 0; ks < 4; ++ks) if (ks < nk) {
                const bf16x8 a = *(const LAS bf16x8*)(tile + (16 * dt + fr) * 136 + 32 * ks + 8 * fq);
                acc = __builtin_amdgcn_mfma_f32_16x16x32_bf16(a, wm[ks], acc, 0, 0, 0);
            }
            const size_t off = (size_t)(tok0 + i0 + fr) * D + g * 128 + 16 * dt + 4 * fq;
            const u32x2 uu = *(const u32x2*)(U + off);
            u32x2 o; o.x = pk2(bflo(uu.x) * (acc[0] + bias), bfhi(uu.x) * (acc[1] + bias)); o.y = pk2(bflo(uu.y) * (acc[2] + bias), bfhi(uu.y) * (acc[3] + bias));
            *(u32x2*)(UG + off) = o;
        }
    }
}

__device__ __forceinline__ int crow(int r, int hi) { return (r & 3) + 8 * (r >> 2) + 4 * hi; }
__device__ __forceinline__ bf16x8 ldg16(const bf16_t* base, unsigned byte_off) { return *(const bf16x8*)((const char*)base + byte_off); }
__device__ __forceinline__ void attn_phase(LAS unsigned char* lds, int vcu, int G, const bf16_t* Q, const bf16_t* K, const bf16_t* VTp, const float* tblg, bf16_t* O, const int wave) {
    const int lane = opaque_lane(), tid = wave * 64 + lane, r32 = lane & 31, hi = lane >> 5;
    LAS float* tb = (LAS float*)lds;
    __syncthreads();
    for (int i = tid; i < NH * 513; i += 512) { const int h = i / 513, j = i - h * 513; tb[h * 516 + j] = tblg[i] * LOG2E; }
    __syncthreads();
    const int gw = vcu * 8 + wave, NGW = G * 8;
    const unsigned rowoff = (unsigned)(r32 * D + 8 * hi) * 2u;
    const unsigned voff = (unsigned)r32 * (unsigned)(M * 2) + 16u * hi;
    for (int idx = gw; idx < NBATCH * 64 * NH; idx += NGW) {
        const int h = idx & 15, c = (idx >> 4) & 63, b = idx >> 10;
        const int tok0 = b * SEQ + c * 64;
        const bf16_t* Qu = Q + (size_t)tok0 * D + h * 64;
        bf16x8 qf[2][4];
#pragma unroll
        for (int qh = 0; qh < 2; ++qh)
#pragma unroll
            for (int d0 = 0; d0 < 4; ++d0) qf[qh][d0] = ldg16(Qu + (size_t)qh * 32 * D + 16 * d0, rowoff);
        f32x16 o[2][2];
#pragma unroll
        for (int a = 0; a < 2; ++a)
#pragma unroll
            for (int e = 0; e < 2; ++e)
#pragma unroll
                for (int r = 0; r < 16; ++r) o[a][e][r] = 0.f;
        float mref[2] = {-1e30f, -1e30f}, lsum[2] = {0.f, 0.f};
        const LAS float* tbh = tb + h * 516;
        const int kc0 = c > 8 ? c - 8 : 0;
        const int nsteps = 2 * (c - kc0 + 1);
        const int ktok0 = b * SEQ + kc0 * 64;
        const bf16_t* Ku = K + (size_t)ktok0 * D + h * 64;
        const bf16_t* Vu = VTp + (size_t)(h * 64) * M + ktok0;
        bf16x8 kf[4];
#pragma unroll
        for (int d0 = 0; d0 < 4; ++d0) kf[d0] = ldg16(Ku + 16 * d0, rowoff);
#pragma unroll 1
        for (int st = 0; st < nsteps; ++st) {
            bf16x8 vf[2][2];
#pragma unroll
            for (int e = 0; e < 2; ++e)
#pragma unroll
                for (int s2 = 0; s2 < 2; ++s2) vf[e][s2] = ldg16(Vu + (size_t)(32 * e) * M + 32 * st + 16 * s2, voff);
            f32x16 p[2];
#pragma unroll
            for (int qh = 0; qh < 2; ++qh) {
                f32x16 acc;
#pragma unroll
                for (int r = 0; r < 16; ++r) acc[r] = 0.f;
#pragma unroll
                for (int d0 = 0; d0 < 4; ++d0) acc = __builtin_amdgcn_mfma_f32_32x32x16_bf16(kf[d0], qf[qh][d0], acc, 0, 0, 0);
                p[qh] = acc;
            }
            if (st + 1 < nsteps) {
#pragma unroll
                for (int d0 = 0; d0 < 4; ++d0) kf[d0] = ldg16(Ku + (size_t)(32 * (st + 1)) * D + 16 * d0, rowoff);
            }
            const int dc = c - kc0 - (st >> 1), kh = st & 1;
            if (dc >= 5) {
                const float bc = tbh[512];
#pragma unroll
                for (int qh = 0; qh < 2; ++qh)
#pragma unroll
                    for (int r = 0; r < 16; ++r) p[qh][r] += bc;
            } else {
                const int dbase = 64 * dc - 32 * kh + r32 - 4 * hi + 256;
#pragma unroll
                for (int qh = 0; qh < 2; ++qh)
#pragma unroll
                    for (int r = 0; r < 16; ++r) {
                        int di = dbase + 32 * qh - ((r & 3) + 8 * (r >> 2));
                        di = di > 512 ? 512 : di;
                        p[qh][r] += tbh[di];
                    }
            }
            bf16x8 pb[2][2];
#pragma unroll
            for (int qh = 0; qh < 2; ++qh) {
                float mt = p[qh][0];
#pragma unroll
                for (int r = 1; r < 16; ++r) mt = fmaxf(mt, p[qh][r]);
                mt = fmaxf(mt, __shfl_xor(mt, 32));
                const float mn = fmaxf(mref[qh], mt), f = __builtin_amdgcn_exp2f(mref[qh] - mn);
                mref[qh] = mn; lsum[qh] *= f;
#pragma unroll
                for (int e = 0; e < 2; ++e)
#pragma unroll
                    for (int r = 0; r < 16; ++r) o[qh][e][r] *= f;
                float sm = 0.f;
#pragma unroll
                for (int r = 0; r < 16; ++r) { const float pe = __builtin_amdgcn_exp2f(p[qh][r] - mn); p[qh][r] = pe; sm += pe; }
                lsum[qh] += sm;
#pragma unroll
                for (int s2 = 0; s2 < 2; ++s2) {
                    const int r0 = 8 * s2;
                    u32x4 w; w.x = pk2(p[qh][r0 + 0], p[qh][r0 + 1]); w.y = pk2(p[qh][r0 + 2], p[qh][r0 + 3]); w.z = pk2(p[qh][r0 + 4], p[qh][r0 + 5]); w.w = pk2(p[qh][r0 + 6], p[qh][r0 + 7]);
                    pb[qh][s2] = __builtin_bit_cast(bf16x8, w);
                }
            }
#pragma unroll
            for (int e = 0; e < 2; ++e)
#pragma unroll
                for (int s2 = 0; s2 < 2; ++s2)
#pragma unroll
                    for (int qh = 0; qh < 2; ++qh) o[qh][e] = __builtin_amdgcn_mfma_f32_32x32x16_bf16(vf[e][s2], pb[qh][s2], o[qh][e], 0, 0, 0);
        }
#pragma unroll
        for (int qh = 0; qh < 2; ++qh) {
            const float lt = lsum[qh] + __shfl_xor(lsum[qh], 32), inv = 1.0f / lt;
            char* op = (char*)(O + (size_t)(tok0 + 32 * qh) * D + h * 64) + (unsigned)(r32 * D + 4 * hi) * 2u;
#pragma unroll
            for (int e = 0; e < 2; ++e)
#pragma unroll
                for (int a = 0; a < 4; ++a) {
                    u32x2 w; w.x = pk2(o[qh][e][4 * a + 0] * inv, o[qh][e][4 * a + 1] * inv); w.y = pk2(o[qh][e][4 * a + 2] * inv, o[qh][e][4 * a + 3] * inv);
                    *(u32x2*)(op + (32 * e + 8 * a) * 2) = w;
                }
        }
    }
}

#define XB_TMO      128
#define XB_XCNT(j)  (256  + 64 * (j))
#define XB_XSUB(j)  (1280 + 64 * (j))
#define XB_XGEN(j)  (2304 + 64 * (j))
#define XB_TOP      3328
#define XB_TOPGEN   3392
#define XCD_BAR_WORDS 3456
#define XB_SPIN_CAP (1u << 18)

__device__ __forceinline__ unsigned xb_ld(unsigned* p)              { return __hip_atomic_load(p, __ATOMIC_RELAXED, __HIP_MEMORY_SCOPE_AGENT); }
__device__ __forceinline__ unsigned xb_add(unsigned* p, unsigned v) { return __hip_atomic_fetch_add(p, v, __ATOMIC_RELAXED, __HIP_MEMORY_SCOPE_AGENT); }
__device__ __forceinline__ unsigned xb_xcc_id() { return (unsigned)__builtin_amdgcn_s_getreg((3 << 11) | 20) & 0xFu; }
#define XB_SPIN(cond, bar) do { unsigned _sp = 0; while (cond) { __builtin_amdgcn_s_sleep(1); \
    if ((++_sp & 255u) == 0u) { if (xb_ld(&(bar)[XB_TMO])) break; if (_sp > XB_SPIN_CAP) { atomicAdd(&(bar)[XB_TMO], 1u); break; } } } } while (0)

struct XcdBarrier {
    unsigned* bar; unsigned x;
    volatile LAS unsigned* st;
};

__device__ __forceinline__ XcdBarrier xcd_barrier_post(unsigned* bar, volatile LAS unsigned* st) {
    XcdBarrier b; b.bar = bar; b.x = xb_xcc_id(); b.st = st;
    if (threadIdx.x == 0) (void)xb_add(&bar[XB_XCNT(b.x)], 1u);
    return b;
}
__device__ __forceinline__ void xcd_barrier_complete(unsigned* bar, unsigned x, unsigned& nloc, unsigned& nx) {
    const unsigned G = gridDim.x * gridDim.y * gridDim.z;
    unsigned sum, cnt, mine, sp = 0u;
    for (;;) {
        sum = 0u; cnt = 0u; mine = 0u;
#pragma unroll
        for (unsigned j = 0; j < 16; ++j) { const unsigned c = xb_ld(&bar[XB_XCNT(j)]); sum += c; cnt += (c > 0u) ? 1u : 0u; mine = (j == x) ? c : mine; }
        if (sum == G) break;
        __builtin_amdgcn_s_sleep(1);
        if ((++sp & 255u) == 0u) { if (xb_ld(&bar[XB_TMO])) break; if (sp > XB_SPIN_CAP) { atomicAdd(&bar[XB_TMO], 1u); break; } }
    }
    nloc = mine > 0u ? mine : 1u; nx = cnt > 0u ? cnt : 1u;
}

__device__ __forceinline__ void xcd_barrier(const XcdBarrier& b) {
    asm volatile("s_waitcnt vmcnt(0)" ::: "memory");
    __syncthreads();
    if (threadIdx.x == 0) {
        unsigned* bar = b.bar;
        __builtin_amdgcn_s_waitcnt(0);
        unsigned nloc = b.st[0], nx = b.st[1];
        if (nloc == 0u) { xcd_barrier_complete(bar, b.x, nloc, nx); b.st[0] = nloc; b.st[1] = nx; }
        const unsigned old = xb_add(&bar[XB_XSUB(b.x)], 1u);
        const unsigned gen = old / nloc;
        if (old + 1u == (gen + 1u) * nloc) {
            __builtin_amdgcn_fence(__ATOMIC_RELEASE, "agent");
            asm volatile("s_waitcnt vmcnt(0)" ::: "memory");
            const unsigned og = xb_add(&bar[XB_TOP], 1u);
            const unsigned tg = og / nx;
            if (og + 1u == (tg + 1u) * nx) xb_add(&bar[XB_TOPGEN], 1u);
            else XB_SPIN(xb_ld(&bar[XB_TOPGEN]) == tg, bar);
            __builtin_amdgcn_fence(__ATOMIC_ACQUIRE, "agent");
            xb_add(&bar[XB_XGEN(b.x)], 1u);
            asm volatile("s_waitcnt vmcnt(0)" ::: "memory");
        } else {
            XB_SPIN(xb_ld(&bar[XB_XGEN(b.x)]) == gen, bar);
            __builtin_amdgcn_fence(__ATOMIC_ACQUIRE, "agent");
            asm volatile("s_waitcnt vmcnt(0)" ::: "memory");
        }
    }
    __syncthreads();
}

#define WSB(off) (opaque_ptr(P.ws) + (off))
__global__ void __launch_bounds__(512, 2) mega_fwd(Params P) {
    extern __shared__ __attribute__((aligned(16))) unsigned char lds_raw[];
    LAS unsigned char* lds = (LAS unsigned char*)lds_raw;
    const int wave = __builtin_amdgcn_readfirstlane((int)threadIdx.x >> 6);
    const int G = gridDim.x, bx = blockIdx.x;
    const int vcu = (G % 8 == 0) ? (bx % 8) * (G / 8) + bx / 8 : bx;
    const int gw = vcu * 8 + wave, NGW = G * 8;
    LAS float* scr = (LAS float*)(lds + wave * 16384);
    volatile LAS unsigned* misc = (volatile LAS unsigned*)(lds + LDS_MISC);
    if (threadIdx.x < 2) misc[threadIdx.x] = 0u;
    __syncthreads();
    const XcdBarrier bar = xcd_barrier_post((unsigned*)(P.ws + WS_BAR), misc);

    convert_layer(P, 0, scr, gw, NGW, opaque_lane());
    rowpass0(gw, NGW, opaque_lane(), P.x, (bf16_t*)WSB(WS_HB), (float*)WSB(WS_RSTD));
    cg::this_grid().sync();

#pragma unroll 1
    for (int layer = 0; layer < 4; ++layer) {
        const float* g = P.norm_g + (size_t)layer * 4 * D;
        if (layer < 2) {
            {
                unsigned char* ws = WSB(0);
                pg8::Gemm gm{(bf16_t*)(ws + WS_HB), (bf16_t*)(ws + WS_WA), M, D, D}; pg8::StaticOrder S; S.init(M, D, G, bx);
                pg8::EpiRow<1> E{(bf16_t*)(ws + WS_U), nullptr, D, 1 << 20, (float*)(ws + WS_RSTD), 1.0f};
                pg8::gemm_phase<pg8::EpiRow<1>, pg8::StaticOrder, true, true>(lds, gm, S, E, wave);
            }
            {
                unsigned char* ws = WSB(0);
                pg8::Gemm gm{(bf16_t*)(ws + WS_WA) + (size_t)D * D, (bf16_t*)(ws + WS_HB), D, M, D}; pg8::StaticOrder S; S.init(D, M, G, bx);
                pg8::EpiCol<0> E{(bf16_t*)(ws + WS_VT), M, (float*)(ws + WS_RSTD), (float*)(ws + WS_LNS), (float*)(ws + WS_LNQ)};
                pg8::gemm_phase<pg8::EpiCol<0>, pg8::StaticOrder, true, true>(lds, gm, S, E, wave);
            }
        } else {
            {
                unsigned char* ws = WSB(0);
                const int N = layer == 2 ? 2 * D : D;
                pg8::Gemm gm{(bf16_t*)(ws + WS_HB), (bf16_t*)(ws + WS_WA), M, N, D}; pg8::StaticOrder S; S.init(M, N, G, bx);
                pg8::EpiRow<0> E{(bf16_t*)(ws + WS_Q), (bf16_t*)(ws + WS_K), D, 4, (float*)(ws + WS_RSTD), QSCALE};
                pg8::gemm_phase<pg8::EpiRow<0>, pg8::StaticOrder, true, true>(lds, gm, S, E, wave);
            }
            if (layer == 2) {
                unsigned char* ws = WSB(0);
                pg8::Gemm gm{(bf16_t*)(ws + WS_WA) + (size_t)2 * D * D, (bf16_t*)(ws + WS_HB), D, M, D}; pg8::StaticOrder S; S.init(D, M, G, bx);
                pg8::EpiCol<1> E{(bf16_t*)(ws + WS_VTA), M, (float*)(ws + WS_RSTD), nullptr, nullptr};
                pg8::gemm_phase<pg8::EpiCol<1>, pg8::StaticOrder, true, true>(lds, gm, S, E, wave);
            }
        }
        xcd_barrier(bar);
        if (layer < 2) {
            unsigned char* ws = WSB(0);
            gate_phase(lds, vcu, G, (const bf16_t*)(ws + WS_U), (const bf16_t*)(ws + WS_VT), (const float*)(ws + WS_LNS), (const float*)(ws + WS_LNQ), P.a_ln_g + layer * D, P.a_ln_b + layer * D,
                       P.a_w_s + (size_t)layer * 8 * 128 * 128, P.a_b_s + layer * 8 * 128, (bf16_t*)(ws + WS_UG), wave);
        } else {
            unsigned char* ws = WSB(0);
            attn_phase(lds, vcu, G, (const bf16_t*)(ws + WS_Q), (const bf16_t*)(ws + WS_K), (const bf16_t*)(ws + WS_VTA), P.b_rel + (size_t)(layer - 2) * NH * 513, (bf16_t*)(ws + WS_O), wave);
        }
        xcd_barrier(bar);
        {
            unsigned char* ws = WSB(0);
            pg8::Gemm gm{layer < 2 ? (const bf16_t*)(ws + WS_UG) : (const bf16_t*)(ws + WS_O), (bf16_t*)(ws + WS_WB), M, D, D}; pg8::StaticOrder S; S.init(M, D, G, bx);
            pg8::EpiSq E{(bf16_t*)(ws + WS_HB), D, (float*)(ws + WS_PSQ)};
            pg8::gemm_phase<pg8::EpiSq, pg8::StaticOrder, true, true>(lds, gm, S, E, wave);
        }
        xcd_barrier(bar);
        { unsigned char* ws = WSB(0); rowpass(gw, NGW, opaque_lane(), layer == 0 ? P.x : P.out, P.out, (bf16_t*)(ws + WS_HB), (const float*)(ws + WS_PSQ), g + D, (float*)(ws + WS_RSTD)); }
        xcd_barrier(bar);
        {
            unsigned char* ws = WSB(0);
            pg8::Gemm gm{(bf16_t*)(ws + WS_HB), (bf16_t*)(ws + WS_WUP), M, FF, D}; pg8::StaticOrder S; S.init(M, FF, G, bx);
            pg8::EpiRow<2> E{(bf16_t*)(ws + WS_T), nullptr, FF, 1 << 20, (float*)(ws + WS_RSTD), 1.0f};
            pg8::gemm_phase<pg8::EpiRow<2>, pg8::StaticOrder, true, true>(lds, gm, S, E, wave);
        }
        xcd_barrier(bar);
        {
            unsigned char* ws = WSB(0);
            pg8::Gemm gm{(bf16_t*)(ws + WS_T), (bf16_t*)(ws + WS_WDN), M, D, FF}; pg8::StaticOrder S; S.init(M, D, G, bx);
            pg8::EpiSq E{(bf16_t*)(ws + WS_HB), D, (float*)(ws + WS_PSQ)};
            pg8::gemm_phase<pg8::EpiSq, pg8::StaticOrder, true, true>(lds, gm, S, E, wave);
        }
        xcd_barrier(bar);
        { unsigned char* ws = WSB(0); rowpass(gw, NGW, opaque_lane(), P.out, P.out, (bf16_t*)(ws + WS_HB), (const float*)(ws + WS_PSQ), g + 3 * D, (float*)(ws + WS_RSTD)); }
        if (layer < 3) { convert_layer(P, layer + 1, scr, gw, NGW, opaque_lane()); xcd_barrier(bar); }
    }
}

extern "C" void kernel_launch(void* const* d_in, const int* in_sizes, int n_in, void* d_out, int out_size, void* d_ws, size_t ws_size, hipStream_t stream) {
    static int grid = 0;
    if (grid == 0) {
        if (n_in != 16 || out_size != M * D || ws_size < WS_END) { fprintf(stderr, "kernel_launch: unexpected shapes: n_in %d out %d ws %zu\n", n_in, out_size, ws_size); grid = -1; return; }
        int dev = 0, cus = 0, per_cu = 0;
        if (hipGetDevice(&dev) != hipSuccess || hipDeviceGetAttribute(&cus, hipDeviceAttributeMultiprocessorCount, dev) != hipSuccess) { grid = -1; return; }
        if (hipFuncSetAttribute((const void*)mega_fwd, hipFuncAttributeMaxDynamicSharedMemorySize, LDS_BYTES) != hipSuccess) { fprintf(stderr, "kernel_launch: hipFuncSetAttribute failed\n"); grid = -1; return; }
        if (hipOccupancyMaxActiveBlocksPerMultiprocessor(&per_cu, (const void*)mega_fwd, 512, LDS_BYTES) != hipSuccess || per_cu < 1) { fprintf(stderr, "kernel_launch: occupancy query failed (%d)\n", per_cu); grid = -1; return; }
        grid = cus * per_cu;
        fprintf(stderr, "kernel_launch: grid %d (%d CUs x %d)\n", grid, cus, per_cu);
    }
    if (grid < 0) return;
    Params p{};
    p.x = (const float*)d_in[0]; p.norm_g = (const float*)d_in[1]; p.a_w_in = (const float*)d_in[2]; p.a_ln_g = (const float*)d_in[3]; p.a_ln_b = (const float*)d_in[4];
    p.a_w_s = (const float*)d_in[5]; p.a_b_s = (const float*)d_in[6]; p.a_w_out = (const float*)d_in[7]; p.kv_norm_g = (const float*)d_in[8]; p.w_k = (const float*)d_in[9];
    p.w_v = (const float*)d_in[10]; p.b_w_q = (const float*)d_in[11]; p.b_rel = (const float*)d_in[12]; p.b_w_o = (const float*)d_in[13]; p.w_up = (const float*)d_in[14]; p.w_down = (const float*)d_in[15];
    p.out = (float*)d_out; p.ws = (unsigned char*)d_ws;
    if (hipMemsetAsync((char*)d_ws + WS_BAR, 0, BAR_ZERO_BYTES, stream) != hipSuccess) { fprintf(stderr, "kernel_launch: memset failed\n"); return; }
    void* args[] = {&p};
    const hipError_t e = hipLaunchCooperativeKernel((const void*)mega_fwd, dim3(grid), dim3(512), args, LDS_BYTES, stream);
    if (e != hipSuccess) fprintf(stderr, "kernel_launch: cooperative launch failed: %s (grid %d)\n", hipGetErrorString(e), grid);
}
```

```cpp
#include <hip/hip_runtime.h>
#include <hip/hip_cooperative_groups.h>
#include <cstdio>
#include <cstdint>
namespace cg = cooperative_groups;
__device__ __forceinline__ int opaque_lane() { int l = __builtin_amdgcn_mbcnt_hi(~0u, __builtin_amdgcn_mbcnt_lo(~0u, 0u)); asm volatile("" : "+v"(l)); return l; }
template <class T> __device__ __forceinline__ T* opaque_ptr(T* p) { asm volatile("" : "+s"(p)); return p; }
namespace pg8 {
#define PG8_LAS __attribute__((address_space(3)))
typedef unsigned short bf16_t;
typedef short bf16x8 __attribute__((ext_vector_type(8)));
typedef float f32x4 __attribute__((ext_vector_type(4)));
typedef unsigned u32x4 __attribute__((ext_vector_type(4)));
constexpr int BM = 256, BK = 64, HALF = 128, HTB = HALF * BK * 2  , STAGE_BYTES = 8 * HTB, NXCD = 8, WGM = 8;

__host__ __device__ __forceinline__ int lds_byte(int r, int c) { const int st = (r >> 4) * 2 + (c >> 5), rr = r & 15, cc = c & 31, ob = rr * 64 + cc * 2; return st * 1024 + (ob ^ (((ob >> 9) & 1) << 5)); }
__host__ __device__ __forceinline__ void stage_rc(int b, int& R, int& C) { const int st = b / 1024, sb = b % 1024, swz = sb ^ (((sb >> 9) & 1) << 5); R = (st >> 1) * 16 + swz / 64; C = (st & 1) * 32 + (swz % 64) / 2; }
__host__ __device__ __forceinline__ int perm32(int rho) { const int n = rho >> 4, i = rho & 15; return 8 * (i >> 2) + 4 * n + (i & 3); }

struct Unit { int pm, pn; };
struct Gemm { const bf16_t* A; const bf16_t* Bt; int M, N, K; };

struct StaticOrder {
    int nM, nN, nwg, G, c;
    __host__ __device__ void init(int M, int N, int G_, int c_) { nM = M / BM; nN = N / BM; nwg = nM * nN; G = G_; c = c_; }
    __host__ __device__ bool next(int i, Unit& u) const {
        const long L = (long)i * G + c; if (L >= nwg) return false;
        int wgid = (int)L; { const int q = nwg / NXCD, r = nwg % NXCD, xcd = wgid % NXCD, off = wgid / NXCD; wgid = (xcd < r ? xcd * (q + 1) : r * (q + 1) + (xcd - r) * q) + off; }
        const int nig = WGM * nN, gid = wgid / nig, fm = gid * WGM, gsz = (nM - fm) < WGM ? (nM - fm) : WGM;
        u.pm = fm + ((wgid % nig) % gsz); u.pn = (wgid % nig) / gsz; return true;
    }
    __device__ __forceinline__ void a_ready(const Unit&) const {}
    __device__ __forceinline__ void done(const Unit&) const {}
};

__device__ __forceinline__ unsigned cvt_pk_bf16(float lo, float hi) { unsigned r; asm volatile("v_cvt_pk_bf16_f32 %0, %1, %2" : "=v"(r) : "v"(lo), "v"(hi)); return r; }
typedef float f32x2 __attribute__((ext_vector_type(2)));
typedef unsigned u32x2 __attribute__((ext_vector_type(2)));
__device__ __forceinline__ float gelu_tanh_f(float x) {
    const float u = x * (0.7978845608f + 0.0356774081f * x * x);
    const float e = __builtin_amdgcn_exp2f(-2.885390082f * u);
    return x * __builtin_amdgcn_rcpf(1.0f + e);
}
template <int ACT> __device__ __forceinline__ f32x4 act4(f32x4 v) {
    if (ACT == 1) { v[0] = gelu_tanh_f(v[0]); v[1] = gelu_tanh_f(v[1]); v[2] = gelu_tanh_f(v[2]); v[3] = gelu_tanh_f(v[3]); }
    if (ACT == 2) { v[0] = fmaxf(v[0], 0.f); v[1] = fmaxf(v[1], 0.f); v[2] = fmaxf(v[2], 0.f); v[3] = fmaxf(v[3], 0.f); v = v * v; }
    return v;
}
template <int ACT> struct EpiRow {
    static constexpr bool PERM = true, AFTER_DRAIN = false;
    bf16_t* O; bf16_t* O2; int ldc; int split_pn; const float* rs; float scale0;
    __device__ __forceinline__ void operator()(const f32x4 (&acc)[2][2][4][2], const Unit& u, int wr, int wc, int fr, int fq) const {
        const int row0 = u.pm * BM + wr * 64 + fr;
        bf16_t* base = O; int colt = u.pn * BM; float sc = scale0;
        if (u.pn >= split_pn) { base = O2; colt -= split_pn * BM; sc = 1.f; }
        const int col0 = colt + wc * 32 + 8 * fq;
#pragma unroll
        for (int ai = 0; ai < 2; ++ai)
#pragma unroll
            for (int m = 0; m < 4; ++m) {
                const int row = row0 + ai * HALF + m * 16;
                const float r = rs[row] * sc;
                bf16_t* rowp = base + (size_t)row * ldc + col0;
#pragma unroll
                for (int bj = 0; bj < 2; ++bj) {
                    const f32x4 v0 = act4<ACT>(acc[ai][bj][m][0] * r), v1 = act4<ACT>(acc[ai][bj][m][1] * r);
                    u32x4 w; w.x = cvt_pk_bf16(v0[0], v0[1]); w.y = cvt_pk_bf16(v0[2], v0[3]); w.z = cvt_pk_bf16(v1[0], v1[1]); w.w = cvt_pk_bf16(v1[2], v1[3]);
                    *(u32x4*)(rowp + bj * HALF) = w;
                }
            }
    }
};
template <int MODE> struct EpiCol {
    static constexpr bool PERM = true, AFTER_DRAIN = false;
    bf16_t* O; int ldc; const float* cs; float* psum; float* psq;
    __device__ __forceinline__ void operator()(const f32x4 (&acc)[2][2][4][2], const Unit& u, int wr, int wc, int fr, int fq) const {
        const int row0 = u.pm * BM + wr * 64 + fr, col0 = u.pn * BM + wc * 32 + 8 * fq;
        f32x4 sv[2][2], s1[2][2], s2[2][2];
#pragma unroll
        for (int bj = 0; bj < 2; ++bj)
#pragma unroll
            for (int n = 0; n < 2; ++n) { sv[bj][n] = *(const f32x4*)(cs + col0 + bj * HALF + 4 * n); s1[bj][n] = (f32x4){0.f, 0.f, 0.f, 0.f}; s2[bj][n] = (f32x4){0.f, 0.f, 0.f, 0.f}; }
#pragma unroll
        for (int ai = 0; ai < 2; ++ai)
#pragma unroll
            for (int m = 0; m < 4; ++m) {
                bf16_t* rowp = O + (size_t)(row0 + ai * HALF + m * 16) * ldc;
#pragma unroll
                for (int bj = 0; bj < 2; ++bj) {
                    if (MODE == 0) {
                        const f32x4 v0 = act4<1>(acc[ai][bj][m][0] * sv[bj][0]), v1 = act4<1>(acc[ai][bj][m][1] * sv[bj][1]);
                        s1[bj][0] += v0; s2[bj][0] += v0 * v0; s1[bj][1] += v1; s2[bj][1] += v1 * v1;
                        u32x4 w; w.x = cvt_pk_bf16(v0[0], v0[1]); w.y = cvt_pk_bf16(v0[2], v0[3]); w.z = cvt_pk_bf16(v1[0], v1[1]); w.w = cvt_pk_bf16(v1[2], v1[3]);
                        *(u32x4*)(rowp + col0 + bj * HALF) = w;
                    } else {
                        const f32x4 v0 = acc[ai][bj][m][0] * sv[bj][0], v1 = acc[ai][bj][m][1] * sv[bj][1];
                        const int gb = u.pn * BM + bj * HALF + wc * 32 + 16 * (fq >> 1) + 4 * (fq & 1);
                        u32x2 a, b; a.x = cvt_pk_bf16(v0[0], v0[1]); a.y = cvt_pk_bf16(v0[2], v0[3]); b.x = cvt_pk_bf16(v1[0], v1[1]); b.y = cvt_pk_bf16(v1[2], v1[3]);
                        *(u32x2*)(rowp + gb) = a; *(u32x2*)(rowp + gb + 8) = b;
                    }
                }
            }
        if (MODE == 0) {
#pragma unroll
            for (int bj = 0; bj < 2; ++bj)
#pragma unroll
                for (int n = 0; n < 2; ++n) {
#pragma unroll
                    for (int e = 0; e < 4; ++e) {
                        float a = s1[bj][n][e], b = s2[bj][n][e];
                        a += __shfl_xor(a, 1); b += __shfl_xor(b, 1); a += __shfl_xor(a, 2); b += __shfl_xor(b, 2);
                        a += __shfl_xor(a, 4); b += __shfl_xor(b, 4); a += __shfl_xor(a, 8); b += __shfl_xor(b, 8);
                        s1[bj][n][e] = a; s2[bj][n][e] = b;
                    }
                    if (fr == 0) {
                        const size_t po = (size_t)(u.pm * 2 + wr) * ldc + col0 + bj * HALF + 4 * n;
                        *(f32x4*)(psum + po) = s1[bj][n]; *(f32x4*)(psq + po) = s2[bj][n];
                    }
                }
        }
    }
};
struct EpiSq {
    static constexpr bool PERM = true, AFTER_DRAIN = false;
    bf16_t* O; int ldc; float* psq;
    __device__ __forceinline__ void operator()(const f32x4 (&acc)[2][2][4][2], const Unit& u, int wr, int wc, int fr, int fq) const {
        const int row0 = u.pm * BM + wr * 64 + fr, col0 = u.pn * BM + wc * 32 + 8 * fq;
#pragma unroll
        for (int ai = 0; ai < 2; ++ai)
#pragma unroll
            for (int m = 0; m < 4; ++m) {
                const int row = row0 + ai * HALF + m * 16;
                bf16_t* rowp = O + (size_t)row * ldc + col0;
                float s = 0.f;
#pragma unroll
                for (int bj = 0; bj < 2; ++bj) {
                    const f32x4 v0 = acc[ai][bj][m][0], v1 = acc[ai][bj][m][1];
                    s += (v0[0] * v0[0] + v0[1] * v0[1]) + (v0[2] * v0[2] + v0[3] * v0[3]) + (v1[0] * v1[0] + v1[1] * v1[1]) + (v1[2] * v1[2] + v1[3] * v1[3]);
                    u32x4 w; w.x = cvt_pk_bf16(v0[0], v0[1]); w.y = cvt_pk_bf16(v0[2], v0[3]); w.z = cvt_pk_bf16(v1[0], v1[1]); w.w = cvt_pk_bf16(v1[2], v1[3]);
                    *(u32x4*)(rowp + bj * HALF) = w;
                }
                s += __shfl_xor(s, 16); s += __shfl_xor(s, 32);
                if (fq == 0) psq[(size_t)row * 16 + u.pn * 4 + wc] = s;
            }
    }
};
template <class Epi, class Sched, bool ALIGN_EPI = false, bool SP2 = false>
__device__ __forceinline__ void gemm_phase(PG8_LAS unsigned char* lds, const Gemm g, const Sched& S, const Epi& E, const int wid) {
    const int lane = opaque_lane(), tid = wid * 64 + lane, wr = wid >> 2, wc = wid & 3, fr = lane & 15, fq = lane >> 4;
    const int K = g.K, nt = K / BK;
    unsigned voffA[2], voffB[2];
#pragma unroll
    for (int i = 0; i < 2; ++i) { int R, C; stage_rc(tid * 16 + i * 8192, R, C); const int Rb = Epi::PERM ? ((R & ~31) + perm32(R & 31)) : R;
        voffA[i] = (unsigned)(R * K + C) * 2u; voffB[i] = (unsigned)(Rb * K + C) * 2u; }
    const size_t kstep = (size_t)(BK * 2);
    const size_t hstep = (size_t)HALF * K * 2;
    const size_t tstep = 2 * hstep;
    const unsigned ldsw = (unsigned)wid * 1024u;
    const int aoff = lds_byte(wr * 64 + fr, fq * 8), boff = lds_byte(wc * 32 + fr, fq * 8);
#define PG8_SA(b, h) (((b) * 2 + (h)) * HTB)
#define PG8_SB(b, h) ((4 + (b) * 2 + (h)) * HTB)
#define PG8_STAGE(bufoff, gbase, voff) do { _Pragma("unroll") for (int _i = 0; _i < 2; ++_i) \
        __builtin_amdgcn_global_load_lds((const unsigned*)((const char*)(gbase) + (voff)[_i]), (PG8_LAS unsigned*)(lds + (bufoff) + ldsw + _i * 8192), 16, 0, 0); } while (0)
#define PG8_LDA(dst, b, h) do { _Pragma("unroll") for (int m = 0; m < 4; ++m) _Pragma("unroll") for (int k = 0; k < 2; ++k) dst[m][k] = *(const PG8_LAS bf16x8*)(lds + PG8_SA(b, h) + aoff + m * 2048 + k * 1024); } while (0)
#define PG8_LDB(dst, b, h) do { _Pragma("unroll") for (int n = 0; n < 2; ++n) _Pragma("unroll") for (int k = 0; k < 2; ++k) dst[n][k] = *(const PG8_LAS bf16x8*)(lds + PG8_SB(b, h) + boff + n * 2048 + k * 1024); } while (0)
#define PG8_MMA(ai, bj, At, Bt) do { __builtin_amdgcn_s_setprio(1); _Pragma("unroll") for (int m = 0; m < 4; ++m) _Pragma("unroll") for (int n = 0; n < 2; ++n) _Pragma("unroll") for (int k = 0; k < 2; ++k) \
        acc[ai][bj][m][n] = __builtin_amdgcn_mfma_f32_16x16x32_bf16(Bt[n][k], At[m][k], acc[ai][bj][m][n], 0, 0, 0); __builtin_amdgcn_s_setprio(0); } while (0)
#define PG8_WAIT_V(n) asm volatile("s_waitcnt vmcnt(" #n ")" ::: "memory")
#define PG8_WAIT_L(n) asm volatile("s_waitcnt lgkmcnt(" #n ")" ::: "memory")
#define PG8_BAR __builtin_amdgcn_s_barrier()
#define PG8_SCHED __builtin_amdgcn_sched_barrier(0)
    Unit cur, nxt; int ui = 0;
    if (!S.next(0, cur)) return;
    f32x4 acc[2][2][4][2];
#pragma unroll
    for (int a = 0; a < 2; ++a)
#pragma unroll
        for (int b = 0; b < 2; ++b)
#pragma unroll
            for (int m = 0; m < 4; ++m)
#pragma unroll
                for (int n = 0; n < 2; ++n) acc[a][b][m][n] = (f32x4){0.f, 0.f, 0.f, 0.f};
    bf16x8 At[4][2], B0[2][2], B1[2][2];
    const char* cA = (const char*)g.A + (size_t)cur.pm * tstep; const char* cB = (const char*)g.Bt + (size_t)cur.pn * tstep;
    S.a_ready(cur);
    if constexpr (SP2) {
        PG8_STAGE(PG8_SB(0, 0), cB, voffB); PG8_STAGE(PG8_SB(0, 1), cB + hstep, voffB); PG8_STAGE(PG8_SA(0, 0), cA, voffA); PG8_STAGE(PG8_SA(0, 1), cA + hstep, voffA);
        if (wr == 1) PG8_BAR;
        PG8_WAIT_V(2); PG8_BAR;
        PG8_STAGE(PG8_SB(1, 0), cB + kstep, voffB); PG8_STAGE(PG8_SA(1, 0), cA + kstep, voffA); PG8_STAGE(PG8_SB(1, 1), cB + hstep + kstep, voffB);
        PG8_WAIT_V(6); PG8_BAR;
    } else {
        PG8_STAGE(PG8_SB(0, 0), cB, voffB); PG8_STAGE(PG8_SA(0, 0), cA, voffA); PG8_STAGE(PG8_SB(0, 1), cB + hstep, voffB); PG8_STAGE(PG8_SA(0, 1), cA + hstep, voffA);
        if (wr == 1) PG8_BAR;
        PG8_WAIT_V(4); PG8_BAR;
        PG8_STAGE(PG8_SB(1, 0), cB + kstep, voffB); PG8_STAGE(PG8_SA(1, 0), cA + kstep, voffA); PG8_STAGE(PG8_SB(1, 1), cB + hstep + kstep, voffB);
        PG8_WAIT_V(6); PG8_BAR;
    }
    for (;;) {
        const bool has_next = S.next(ui + 1, nxt);
        const char* nA = has_next ? (const char*)g.A + (size_t)nxt.pm * tstep : cA; const char* nB = has_next ? (const char*)g.Bt + (size_t)nxt.pn * tstep : cB;
        for (int t = 0; t < nt; t += 2) {
            const bool last = (t == nt - 2);
            const char* a1 = cA + (size_t)(t + 1) * kstep;
            const char* a2 = last ? nA : cA + (size_t)(t + 2) * kstep; const char* b2 = last ? nB : cB + (size_t)(t + 2) * kstep;
            const char* a3 = a2 + kstep; const char* b3 = b2 + kstep;
            if (last && has_next) S.a_ready(nxt);
            if constexpr (SP2) {
            PG8_LDB(B0, 0, 0); PG8_LDB(B1, 0, 1); PG8_SCHED; PG8_LDA(At, 0, 0); PG8_STAGE(PG8_SA(1, 1), a1 + hstep, voffA);
            PG8_WAIT_V(8); PG8_WAIT_L(0); PG8_BAR; PG8_MMA(0, 0, At, B0); PG8_MMA(0, 1, At, B1); PG8_BAR; PG8_SCHED;
            PG8_LDA(At, 0, 1); PG8_STAGE(PG8_SB(0, 0), b2, voffB); PG8_STAGE(PG8_SB(0, 1), b2 + hstep, voffB); PG8_STAGE(PG8_SA(0, 0), a2, voffA);
            PG8_WAIT_V(8); PG8_WAIT_L(0); PG8_BAR; PG8_MMA(1, 0, At, B0); PG8_MMA(1, 1, At, B1); PG8_BAR; PG8_SCHED;
            PG8_LDB(B0, 1, 0); PG8_LDB(B1, 1, 1); PG8_SCHED; PG8_LDA(At, 1, 0); PG8_STAGE(PG8_SA(0, 1), a2 + hstep, voffA);
            PG8_WAIT_V(8); PG8_WAIT_L(0); PG8_BAR; PG8_MMA(0, 0, At, B0); PG8_MMA(0, 1, At, B1); PG8_BAR; PG8_SCHED;
            PG8_LDA(At, 1, 1); PG8_STAGE(PG8_SB(1, 0), b3, voffB); PG8_STAGE(PG8_SB(1, 1), b3 + hstep, voffB); PG8_STAGE(PG8_SA(1, 0), a3, voffA);
            PG8_WAIT_V(8); PG8_WAIT_L(0); PG8_BAR; PG8_MMA(1, 0, At, B0); PG8_MMA(1, 1, At, B1); PG8_BAR; PG8_SCHED;
            } else {
            PG8_LDB(B0, 0, 0); PG8_SCHED; PG8_LDA(At, 0, 0); PG8_STAGE(PG8_SA(1, 1), a1 + hstep, voffA);
            PG8_WAIT_L(8); PG8_BAR; PG8_WAIT_L(0); PG8_MMA(0, 0, At, B0); PG8_BAR; PG8_SCHED;
            PG8_LDB(B1, 0, 1); PG8_STAGE(PG8_SB(0, 0), b2, voffB);
            PG8_BAR; PG8_WAIT_L(0); PG8_MMA(0, 1, At, B1); PG8_BAR;
            PG8_LDA(At, 0, 1); PG8_STAGE(PG8_SA(0, 0), a2, voffA);
            PG8_BAR; PG8_WAIT_L(0); PG8_MMA(1, 0, At, B0); PG8_BAR; PG8_SCHED;
            PG8_STAGE(PG8_SB(0, 1), b2 + hstep, voffB);
            PG8_WAIT_V(6); PG8_BAR; PG8_MMA(1, 1, At, B1); PG8_BAR;
            PG8_LDB(B0, 1, 0); PG8_SCHED; PG8_LDA(At, 1, 0); PG8_STAGE(PG8_SA(0, 1), a2 + hstep, voffA);
            PG8_WAIT_L(8); PG8_BAR; PG8_WAIT_L(0); PG8_MMA(0, 0, At, B0); PG8_BAR; PG8_SCHED;
            PG8_LDB(B1, 1, 1); PG8_STAGE(PG8_SB(1, 0), b3, voffB);
            PG8_BAR; PG8_WAIT_L(0); PG8_MMA(0, 1, At, B1); PG8_BAR;
            PG8_LDA(At, 1, 1); PG8_STAGE(PG8_SA(1, 0), a3, voffA);
            PG8_BAR; PG8_WAIT_L(0); PG8_MMA(1, 0, At, B0); PG8_BAR; PG8_SCHED;
            PG8_STAGE(PG8_SB(1, 1), b3 + hstep, voffB);
            PG8_WAIT_V(6); PG8_BAR; PG8_MMA(1, 1, At, B1); PG8_BAR;
            }
        }
        if constexpr (ALIGN_EPI) { if (wr == 0) PG8_BAR; }
        if constexpr (!Epi::AFTER_DRAIN) { E(acc, cur, wr, wc, fr, fq); S.done(cur); }
        if (!has_next) break;
#pragma unroll
        for (int a = 0; a < 2; ++a)
#pragma unroll
            for (int b = 0; b < 2; ++b)
#pragma unroll
                for (int m = 0; m < 4; ++m)
#pragma unroll
                    for (int n = 0; n < 2; ++n) acc[a][b][m][n] = (f32x4){0.f, 0.f, 0.f, 0.f};
        cur = nxt; cA = nA; cB = nB; ++ui;
        if constexpr (ALIGN_EPI) { if (wr == 1) PG8_BAR; }
    }
    PG8_WAIT_V(0);
    if constexpr (!ALIGN_EPI) { if (wr == 0) PG8_BAR; }
    PG8_BAR;
    if constexpr (Epi::AFTER_DRAIN) { E.fused(acc, cur, wr, wc, fr, fq, lds, wid, lane); S.done(cur); }
#undef PG8_SA
#undef PG8_SB
#undef PG8_STAGE
#undef PG8_LDA
#undef PG8_LDB
#undef PG8_MMA
#undef PG8_WAIT_V
#undef PG8_WAIT_L
#undef PG8_BAR
#undef PG8_SCHED
}
}

#define LAS __attribute__((address_space(3)))
typedef unsigned short bf16_t;
typedef float f32x4 __attribute__((ext_vector_type(4)));
typedef float f32x16 __attribute__((ext_vector_type(16)));
typedef unsigned u32x4 __attribute__((ext_vector_type(4)));
typedef unsigned u32x2 __attribute__((ext_vector_type(2)));
typedef short bf16x8 __attribute__((ext_vector_type(8)));
constexpr int D = 1024, SEQ = 4096, NBATCH = 4, M = NBATCH * SEQ, FF = 4096, NH = 16;
constexpr size_t MiB = 1u << 20;
constexpr size_t WS_RSTD = 0, WS_PSQ = 1 * MiB, WS_LNS = 2 * MiB, WS_LNQ = 2 * MiB + 512 * 1024;
constexpr size_t WS_WA = 4 * MiB, WS_WB = 10 * MiB, WS_WUP = 12 * MiB, WS_WDN = 20 * MiB;
constexpr size_t WS_HB = 28 * MiB, WS_T = 60 * MiB, WS_U = 60 * MiB, WS_VT = 92 * MiB, WS_UG = 124 * MiB, WS_Q = 60 * MiB, WS_O = 92 * MiB;
constexpr size_t WS_K = 188 * MiB, WS_VTA = 220 * MiB, WS_END = 252 * MiB;
constexpr size_t WS_BAR = 3 * MiB, BAR_ZERO_BYTES = 16384;
constexpr int LDS_BYTES = 147456, LDS_MISC = 131072 + 512;
constexpr float LOG2E = 1.4426950408889634f;
constexpr float QSCALE = 0.125f * LOG2E;

__device__ __forceinline__ float wave_sum(float v) {
#pragma unroll
    for (int o = 1; o < 64; o <<= 1) v += __shfl_xor(v, o);
    return v;
}
__device__ __forceinline__ unsigned pk2(float lo, float hi) { return pg8::cvt_pk_bf16(lo, hi); }
__device__ __forceinline__ float bflo(unsigned w) { return __uint_as_float(w << 16); }
__device__ __forceinline__ float bfhi(unsigned w) { return __uint_as_float(w & 0xffff0000u); }

__device__ __forceinline__ void transpose_item(const float* W, const float* gain, int K, int N, bf16_t* WT, LAS float* scr, int item, int lane) {
    const int nblk = N / 32, kb = item / nblk, nb = item % nblk, k0 = 64 * kb, n0 = 32 * nb;
    const int kr = lane >> 3, nc = lane & 7;
    f32x4 w[8];
#pragma unroll
    for (int i = 0; i < 8; ++i) w[i] = *(const f32x4*)(W + (size_t)(k0 + 8 * i + kr) * N + n0 + 4 * nc);
    if (gain) {
#pragma unroll
        for (int i = 0; i < 8; ++i) w[i] = w[i] * gain[k0 + 8 * i + kr];
    }
#pragma unroll
    for (int i = 0; i < 8; ++i) { LAS float* d = scr + (8 * i + kr) * 33 + 4 * nc; d[0] = w[i][0]; d[1] = w[i][1]; d[2] = w[i][2]; d[3] = w[i][3]; }
    asm volatile("s_waitcnt lgkmcnt(0)" ::: "memory");
    const int c = lane & 7;
#pragma unroll
    for (int j = 0; j < 4; ++j) { const int n = (lane >> 3) + 8 * j; const LAS float* s = scr + (8 * c) * 33 + n;
        u32x4 o; o.x = pk2(s[0 * 33], s[1 * 33]); o.y = pk2(s[2 * 33], s[3 * 33]); o.z = pk2(s[4 * 33], s[5 * 33]); o.w = pk2(s[6 * 33], s[7 * 33]);
        *(u32x4*)(WT + (size_t)(n0 + n) * K + k0 + 8 * c) = o; }
    asm volatile("s_waitcnt lgkmcnt(0)" ::: "memory");
}
__device__ __forceinline__ void convert_job(const float* W, const float* gain, int K, int N, bf16_t* WT, int off, LAS float* scr, int gw, int NGW, int lane) {
    const int nitems = (K / 64) * (N / 32);
    int it0 = gw - off; if (it0 < 0) it0 += NGW;
    for (int it = it0; it < nitems; it += NGW) transpose_item(W, gain, K, N, WT, scr, it, lane);
}

struct Params {
    const float *x, *norm_g, *a_w_in, *a_ln_g, *a_ln_b, *a_w_s, *a_b_s, *a_w_out, *kv_norm_g, *w_k, *w_v, *b_w_q, *b_rel, *b_w_o, *w_up, *w_down;
    float* out; unsigned char* ws;
};

__device__ __forceinline__ void convert_layer(const Params& P, int layer, LAS float* scr, int gw, int NGW, int lane) {
    unsigned char* ws = opaque_ptr(P.ws);
    const float* g = P.norm_g + (size_t)layer * 4 * D;
    const int q1 = NGW / 4;
    if (layer < 2) {
        convert_job(P.a_w_in + (size_t)layer * D * 2048, g, D, 2048, (bf16_t*)(ws + WS_WA), 0, scr, gw, NGW, lane);
        convert_job(P.a_w_out + (size_t)layer * D * D, nullptr, D, D, (bf16_t*)(ws + WS_WB), 2 * q1, scr, gw, NGW, lane);
    } else {
        const int j = layer - 2;
        convert_job(P.b_w_q + (size_t)j * D * D, g, D, D, (bf16_t*)(ws + WS_WA), 0, scr, gw, NGW, lane);
        if (layer == 2) {
            convert_job(P.w_k, P.kv_norm_g, D, D, (bf16_t*)(ws + WS_WA) + (size_t)D * D, q1, scr, gw, NGW, lane);
            convert_job(P.w_v, P.kv_norm_g, D, D, (bf16_t*)(ws + WS_WA) + (size_t)2 * D * D, 2 * q1, scr, gw, NGW, lane);
        }
        convert_job(P.b_w_o + (size_t)j * D * D, nullptr, D, D, (bf16_t*)(ws + WS_WB), 3 * q1, scr, gw, NGW, lane);
    }
    convert_job(P.w_up + (size_t)layer * D * FF, g + 2 * D, D, FF, (bf16_t*)(ws + WS_WUP), 0, scr, gw, NGW, lane);
    convert_job(P.w_down + (size_t)layer * FF * D, nullptr, FF, D, (bf16_t*)(ws + WS_WDN), 0, scr, gw, NGW, lane);
}

__device__ __forceinline__ void rowpass0(int gw, int NGW, int lane, const float* x, bf16_t* hb, float* rstd) {
    for (int row0 = gw * 4; row0 < M; row0 += NGW * 4) {
        f32x4 hv[4][4]; float sq[4];
#pragma unroll
        for (int rr = 0; rr < 4; ++rr)
#pragma unroll
            for (int j = 0; j < 4; ++j) hv[rr][j] = *(const f32x4*)(x + (size_t)(row0 + rr) * D + 4 * lane + 256 * j);
#pragma unroll
        for (int rr = 0; rr < 4; ++rr) { float s = 0.f;
#pragma unroll
            for (int j = 0; j < 4; ++j) s += (hv[rr][j][0] * hv[rr][j][0] + hv[rr][j][1] * hv[rr][j][1]) + (hv[rr][j][2] * hv[rr][j][2] + hv[rr][j][3] * hv[rr][j][3]);
            sq[rr] = s; }
#pragma unroll
        for (int o = 1; o < 64; o <<= 1) { sq[0] += __shfl_xor(sq[0], o); sq[1] += __shfl_xor(sq[1], o); sq[2] += __shfl_xor(sq[2], o); sq[3] += __shfl_xor(sq[3], o); }
        if (lane < 4) { const float sv = lane == 0 ? sq[0] : lane == 1 ? sq[1] : lane == 2 ? sq[2] : sq[3]; rstd[row0 + lane] = 1.0f / sqrtf(sv * (1.0f / D) + 1e-6f); }
#pragma unroll
        for (int rr = 0; rr < 4; ++rr)
#pragma unroll
            for (int j = 0; j < 4; ++j) { u32x2 w; w.x = pk2(hv[rr][j][0], hv[rr][j][1]); w.y = pk2(hv[rr][j][2], hv[rr][j][3]); *(u32x2*)(hb + (size_t)(row0 + rr) * D + 4 * lane + 256 * j) = w; }
    }
}
__device__ __forceinline__ void rowpass(int gw, int NGW, int lane, bf16_t* hb, const bf16_t* mb, const float* psq, const float* g, float* rstd, float* fout) {
    f32x4 gv[4];
#pragma unroll
    for (int j = 0; j < 4; ++j) gv[j] = *(const f32x4*)(g + 4 * lane + 256 * j);
    for (int row0 = gw * 4; row0 < M; row0 += NGW * 4) {
        float mq = psq[(size_t)row0 * 16 + lane];
        u32x2 mr[4][4], hr[4][4];
#pragma unroll
        for (int rr = 0; rr < 4; ++rr)
#pragma unroll
            for (int j = 0; j < 4; ++j) { const size_t o = (size_t)(row0 + rr) * D + 4 * lane + 256 * j; mr[rr][j] = *(const u32x2*)(mb + o); hr[rr][j] = *(const u32x2*)(hb + o); }
        mq += __shfl_xor(mq, 1); mq += __shfl_xor(mq, 2); mq += __shfl_xor(mq, 4); mq += __shfl_xor(mq, 8);
        float sq[4]; f32x4 hv[4][4];
#pragma unroll
        for (int rr = 0; rr < 4; ++rr) {
            const float rm = 1.0f / sqrtf(__shfl(mq, 16 * rr) * (1.0f / D) + 1e-6f);
            float s = 0.f;
#pragma unroll
            for (int j = 0; j < 4; ++j) {
                f32x4 mv, h0; mv[0] = bflo(mr[rr][j].x); mv[1] = bfhi(mr[rr][j].x); mv[2] = bflo(mr[rr][j].y); mv[3] = bfhi(mr[rr][j].y);
                h0[0] = bflo(hr[rr][j].x); h0[1] = bfhi(hr[rr][j].x); h0[2] = bflo(hr[rr][j].y); h0[3] = bfhi(hr[rr][j].y);
                hv[rr][j] = h0 + mv * rm * gv[j];
                s += (hv[rr][j][0] * hv[rr][j][0] + hv[rr][j][1] * hv[rr][j][1]) + (hv[rr][j][2] * hv[rr][j][2] + hv[rr][j][3] * hv[rr][j][3]);
            }
            sq[rr] = s;
        }
        if (fout) {
#pragma unroll
            for (int rr = 0; rr < 4; ++rr)
#pragma unroll
                for (int j = 0; j < 4; ++j) *(f32x4*)(fout + (size_t)(row0 + rr) * D + 4 * lane + 256 * j) = hv[rr][j];
        } else {
#pragma unroll
            for (int o = 1; o < 64; o <<= 1) { sq[0] += __shfl_xor(sq[0], o); sq[1] += __shfl_xor(sq[1], o); sq[2] += __shfl_xor(sq[2], o); sq[3] += __shfl_xor(sq[3], o); }
            if (lane < 4) { const float sv = lane == 0 ? sq[0] : lane == 1 ? sq[1] : lane == 2 ? sq[2] : sq[3]; rstd[row0 + lane] = 1.0f / sqrtf(sv * (1.0f / D) + 1e-6f); }
#pragma unroll
            for (int rr = 0; rr < 4; ++rr)
#pragma unroll
                for (int j = 0; j < 4; ++j) { u32x2 w; w.x = pk2(hv[rr][j][0], hv[rr][j][1]); w.y = pk2(hv[rr][j][2], hv[rr][j][3]); *(u32x2*)(hb + (size_t)(row0 + rr) * D + 4 * lane + 256 * j) = w; }
        }
    }
}

__device__ __forceinline__ void gate_phase(LAS unsigned char* lds, int vcu, int G, const bf16_t* U, const bf16_t* VT, const float* psum, const float* psq,
                                           const float* lng, const float* lnb, const float* wsp, const float* bsp, bf16_t* UG, const int wave) {
    const int lane = opaque_lane(), tid = wave * 64 + lane, fr = lane & 15, fq = lane >> 4;
    LAS bf16_t* tile = (LAS bf16_t*)lds;
    LAS float* st = (LAS float*)(lds + 36864);
    for (int unit = vcu; unit < 1024; unit += G) {
        const int nb = unit >> 3, g = unit & 7, tok0 = nb * 128;
        __syncthreads();
        if (tid < 128) {
            float s = 0.f, q = 0.f;
#pragma unroll
            for (int p = 0; p < 8; ++p) { s += psum[(size_t)p * M + tok0 + tid]; q += psq[(size_t)p * M + tok0 + tid]; }
            const float mu = s * (1.0f / 1024), var = q * (1.0f / 1024) - mu * mu;
            st[2 * tid] = mu; st[2 * tid + 1] = 1.0f / sqrtf(fmaxf(var, 0.f) + 1e-5f);
        }
        __syncthreads();
#pragma unroll
        for (int r = 0; r < 4; ++r) {
            const int q = tid + 512 * r, d = q >> 4, jc = q & 15;
            const u32x4 raw = *(const u32x4*)(VT + (size_t)(g * 128 + d) * M + tok0 + 8 * jc);
            const float lg = lng[g * 128 + d], lb = lnb[g * 128 + d];
            const f32x4 s0 = *(const LAS f32x4*)(st + 16 * jc), s1 = *(const LAS f32x4*)(st + 16 * jc + 4), s2 = *(const LAS f32x4*)(st + 16 * jc + 8), s3 = *(const LAS f32x4*)(st + 16 * jc + 12);
            u32x4 o;
            o.x = pk2((bflo(raw.x) - s0[0]) * s0[1] * lg + lb, (bfhi(raw.x) - s0[2]) * s0[3] * lg + lb);
            o.y = pk2((bflo(raw.y) - s1[0]) * s1[1] * lg + lb, (bfhi(raw.y) - s1[2]) * s1[3] * lg + lb);
            o.z = pk2((bflo(raw.z) - s2[0]) * s2[1] * lg + lb, (bfhi(raw.z) - s2[2]) * s2[3] * lg + lb);
            o.w = pk2((bflo(raw.w) - s3[0]) * s3[1] * lg + lb, (bfhi(raw.w) - s3[2]) * s3[3] * lg + lb);
            *(LAS u32x4*)(tile + d * 136 + 8 * jc) = o;
        }
        __syncthreads();
        const int i0 = 16 * wave, nk = wave < 4 ? 2 : 4;
        bf16x8 wm[4];
#pragma unroll
        for (int ks = 0; ks < 4; ++ks) {
            u32x4 w = (u32x4){0u, 0u, 0u, 0u};
            if (ks < nk) { const float* wp = wsp + ((size_t)g * 128 + i0 + fr) * 128 + 32 * ks + 8 * fq; const f32x4 a = *(const f32x4*)wp, b = *(const f32x4*)(wp + 4);
                w.x = pk2(a[0], a[1]); w.y = pk2(a[2], a[3]); w.z = pk2(b[0], b[1]); w.w = pk2(b[2], b[3]); }
            wm[ks] = __builtin_bit_cast(bf16x8, w);
        }
        const float bias = bsp[g * 128 + i0 + fr];
#pragma unroll
        for (int dt = 0; dt < 8; ++dt) {
            f32x4 acc = (f32x4){0.f, 0.f, 0.f, 0.f};
#pragma unroll
            for (int ks = 0; ks < 4; ++ks) if (ks < nk) {
                const bf16x8 a = *(const LAS bf16x8*)(tile + (16 * dt + fr) * 136 + 32 * ks + 8 * fq);
                acc = __builtin_amdgcn_mfma_f32_16x16x32_bf16(a, wm[ks], acc, 0, 0, 0);
            }
            const size_t off = (size_t)(tok0 + i0 + fr) * D + g * 128 + 16 * dt + 4 * fq;
            const u32x2 uu = *(const u32x2*)(U + off);
            u32x2 o; o.x = pk2(bflo(uu.x) * (acc[0] + bias), bfhi(uu.x) * (acc[1] + bias)); o.y = pk2(bflo(uu.y) * (acc[2] + bias), bfhi(uu.y) * (acc[3] + bias));
            *(u32x2*)(UG + off) = o;
        }
    }
}

__device__ __forceinline__ int crow(int r, int hi) { return (r & 3) + 8 * (r >> 2) + 4 * hi; }
__device__ __forceinline__ bf16x8 ldg16(const bf16_t* base, unsigned byte_off) { return *(const bf16x8*)((const char*)base + byte_off); }
__device__ __forceinline__ void attn_phase(LAS unsigned char* lds, int vcu, int G, const bf16_t* Q, const bf16_t* K, const bf16_t* VTp, const float* tblg, bf16_t* O, const int wave) {
    const int lane = opaque_lane(), tid = wave * 64 + lane, r32 = lane & 31, hi = lane >> 5;
    LAS float* tb = (LAS float*)lds;
    __syncthreads();
    for (int i = tid; i < NH * 513; i += 512) { const int h = i / 513, j = i - h * 513; tb[h * 516 + j] = tblg[i] * LOG2E; }
    __syncthreads();
    const int gw = vcu * 8 + wave, NGW = G * 8;
    const unsigned rowoff = (unsigned)(r32 * D + 8 * hi) * 2u;
    const unsigned voff = (unsigned)r32 * (unsigned)(M * 2) + 16u * hi;
    for (int idx = gw; idx < NBATCH * 64 * NH; idx += NGW) {
        const int h = idx & 15, c = (idx >> 4) & 63, b = idx >> 10;
        const int tok0 = b * SEQ + c * 64;
        const bf16_t* Qu = Q + (size_t)tok0 * D + h * 64;
        bf16x8 qf[2][4];
#pragma unroll
        for (int qh = 0; qh < 2; ++qh)
#pragma unroll
            for (int d0 = 0; d0 < 4; ++d0) qf[qh][d0] = ldg16(Qu + (size_t)qh * 32 * D + 16 * d0, rowoff);
        f32x16 o[2][2];
#pragma unroll
        for (int a = 0; a < 2; ++a)
#pragma unroll
            for (int e = 0; e < 2; ++e)
#pragma unroll
                for (int r = 0; r < 16; ++r) o[a][e][r] = 0.f;
        float mref[2] = {-1e30f, -1e30f}, lsum[2] = {0.f, 0.f};
        const LAS float* tbh = tb + h * 516;
        const int kc0 = c > 8 ? c - 8 : 0;
        const int nsteps = 2 * (c - kc0 + 1);
        const int ktok0 = b * SEQ + kc0 * 64;
        const bf16_t* Ku = K + (size_t)ktok0 * D + h * 64;
        const bf16_t* Vu = VTp + (size_t)(h * 64) * M + ktok0;
        bf16x8 kf[4];
#pragma unroll
        for (int d0 = 0; d0 < 4; ++d0) kf[d0] = ldg16(Ku + 16 * d0, rowoff);
#pragma unroll 1
        for (int st = 0; st < nsteps; ++st) {
            bf16x8 vf[2][2];
#pragma unroll
            for (int e = 0; e < 2; ++e)
#pragma unroll
                for (int s2 = 0; s2 < 2; ++s2) vf[e][s2] = ldg16(Vu + (size_t)(32 * e) * M + 32 * st + 16 * s2, voff);
            f32x16 p[2];
#pragma unroll
            for (int qh = 0; qh < 2; ++qh) {
                f32x16 acc;
#pragma unroll
                for (int r = 0; r < 16; ++r) acc[r] = 0.f;
#pragma unroll
                for (int d0 = 0; d0 < 4; ++d0) acc = __builtin_amdgcn_mfma_f32_32x32x16_bf16(kf[d0], qf[qh][d0], acc, 0, 0, 0);
                p[qh] = acc;
            }
            if (st + 1 < nsteps) {
#pragma unroll
                for (int d0 = 0; d0 < 4; ++d0) kf[d0] = ldg16(Ku + (size_t)(32 * (st + 1)) * D + 16 * d0, rowoff);
            }
            const int dc = c - kc0 - (st >> 1), kh = st & 1;
            if (dc >= 5) {
                const float bc = tbh[512];
#pragma unroll
                for (int qh = 0; qh < 2; ++qh)
#pragma unroll
                    for (int r = 0; r < 16; ++r) p[qh][r] += bc;
            } else {
                const int dbase = 64 * dc - 32 * kh + r32 - 4 * hi + 256;
#pragma unroll
                for (int qh = 0; qh < 2; ++qh)
#pragma unroll
                    for (int r = 0; r < 16; ++r) {
                        int di = dbase + 32 * qh - ((r & 3) + 8 * (r >> 2));
                        di = di > 512 ? 512 : di;
                        p[qh][r] += tbh[di];
                    }
            }
            bf16x8 pb[2][2];
#pragma unroll
            for (int qh = 0; qh < 2; ++qh) {
                float mt = p[qh][0];
#pragma unroll
                for (int r = 1; r < 16; ++r) mt = fmaxf(mt, p[qh][r]);
                mt = fmaxf(mt, __shfl_xor(mt, 32));
                const float mn = fmaxf(mref[qh], mt), f = __builtin_amdgcn_exp2f(mref[qh] - mn);
                mref[qh] = mn; lsum[qh] *= f;
#pragma unroll
                for (int e = 0; e < 2; ++e)
#pragma unroll
                    for (int r = 0; r < 16; ++r) o[qh][e][r] *= f;
                float sm = 0.f;
#pragma unroll
                for (int r = 0; r < 16; ++r) { const float pe = __builtin_amdgcn_exp2f(p[qh][r] - mn); p[qh][r] = pe; sm += pe; }
                lsum[qh] += sm;
#pragma unroll
                for (int s2 = 0; s2 < 2; ++s2) {
                    const int r0 = 8 * s2;
                    u32x4 w; w.x = pk2(p[qh][r0 + 0], p[qh][r0 + 1]); w.y = pk2(p[qh][r0 + 2], p[qh][r0 + 3]); w.z = pk2(p[qh][r0 + 4], p[qh][r0 + 5]); w.w = pk2(p[qh][r0 + 6], p[qh][r0 + 7]);
                    pb[qh][s2] = __builtin_bit_cast(bf16x8, w);
                }
            }
#pragma unroll
            for (int e = 0; e < 2; ++e)
#pragma unroll
                for (int s2 = 0; s2 < 2; ++s2)
#pragma unroll
                    for (int qh = 0; qh < 2; ++qh) o[qh][e] = __builtin_amdgcn_mfma_f32_32x32x16_bf16(vf[e][s2], pb[qh][s2], o[qh][e], 0, 0, 0);
        }
#pragma unroll
        for (int qh = 0; qh < 2; ++qh) {
            const float lt = lsum[qh] + __shfl_xor(lsum[qh], 32), inv = 1.0f / lt;
            char* op = (char*)(O + (size_t)(tok0 + 32 * qh) * D + h * 64) + (unsigned)(r32 * D + 4 * hi) * 2u;
#pragma unroll
            for (int e = 0; e < 2; ++e)
#pragma unroll
                for (int a = 0; a < 4; ++a) {
                    u32x2 w; w.x = pk2(o[qh][e][4 * a + 0] * inv, o[qh][e][4 * a + 1] * inv); w.y = pk2(o[qh][e][4 * a + 2] * inv, o[qh][e][4 * a + 3] * inv);
                    *(u32x2*)(op + (32 * e + 8 * a) * 2) = w;
                }
        }
    }
}

#define XB_TMO      128
#define XB_XCNT(j)  (256  + 64 * (j))
#define XB_XSUB(j)  (1280 + 64 * (j))
#define XB_XGEN(j)  (2304 + 64 * (j))
#define XB_TOP      3328
#define XB_TOPGEN   3392
#define XCD_BAR_WORDS 3456
#define XB_SPIN_CAP (1u << 18)

__device__ __forceinline__ unsigned xb_ld(unsigned* p)              { return __hip_atomic_load(p, __ATOMIC_RELAXED, __HIP_MEMORY_SCOPE_AGENT); }
__device__ __forceinline__ unsigned xb_add(unsigned* p, unsigned v) { return __hip_atomic_fetch_add(p, v, __ATOMIC_RELAXED, __HIP_MEMORY_SCOPE_AGENT); }
__device__ __forceinline__ unsigned xb_xcc_id() { return (unsigned)__builtin_amdgcn_s_getreg((3 << 11) | 20) & 0xFu; }
#define XB_SPIN(cond, bar) do { unsigned _sp = 0; while (cond) { __builtin_amdgcn_s_sleep(1); \
    if ((++_sp & 255u) == 0u) { if (xb_ld(&(bar)[XB_TMO])) break; if (_sp > XB_SPIN_CAP) { atomicAdd(&(bar)[XB_TMO], 1u); break; } } } } while (0)

struct XcdBarrier {
    unsigned* bar; unsigned x;
    volatile LAS unsigned* st;
};

__device__ __forceinline__ XcdBarrier xcd_barrier_post(unsigned* bar, volatile LAS unsigned* st) {
    XcdBarrier b; b.bar = bar; b.x = xb_xcc_id(); b.st = st;
    if (threadIdx.x == 0) (void)xb_add(&bar[XB_XCNT(b.x)], 1u);
    return b;
}
__device__ __forceinline__ void xcd_barrier_complete(unsigned* bar, unsigned x, unsigned& nloc, unsigned& nx) {
    const unsigned G = gridDim.x * gridDim.y * gridDim.z;
    unsigned sum, cnt, mine, sp = 0u;
    for (;;) {
        sum = 0u; cnt = 0u; mine = 0u;
#pragma unroll
        for (unsigned j = 0; j < 16; ++j) { const unsigned c = xb_ld(&bar[XB_XCNT(j)]); sum += c; cnt += (c > 0u) ? 1u : 0u; mine = (j == x) ? c : mine; }
        if (sum == G) break;
        __builtin_amdgcn_s_sleep(1);
        if ((++sp & 255u) == 0u) { if (xb_ld(&bar[XB_TMO])) break; if (sp > XB_SPIN_CAP) { atomicAdd(&bar[XB_TMO], 1u); break; } }
    }
    nloc = mine > 0u ? mine : 1u; nx = cnt > 0u ? cnt : 1u;
}

__device__ __forceinline__ void xcd_barrier(const XcdBarrier& b) {
    asm volatile("s_waitcnt vmcnt(0)" ::: "memory");
    __syncthreads();
    if (threadIdx.x == 0) {
        unsigned* bar = b.bar;
        __builtin_amdgcn_s_waitcnt(0);
        unsigned nloc = b.st[0], nx = b.st[1];
        if (nloc == 0u) { xcd_barrier_complete(bar, b.x, nloc, nx); b.st[0] = nloc; b.st[1] = nx; }
        const unsigned old = xb_add(&bar[XB_XSUB(b.x)], 1u);
        const unsigned gen = old / nloc;
        if (old + 1u == (gen + 1u) * nloc) {
            __builtin_amdgcn_fence(__ATOMIC_RELEASE, "agent");
            asm volatile("s_waitcnt vmcnt(0)" ::: "memory");
            const unsigned og = xb_add(&bar[XB_TOP], 1u);
            const unsigned tg = og / nx;
            if (og + 1u == (tg + 1u) * nx) xb_add(&bar[XB_TOPGEN], 1u);
            else XB_SPIN(xb_ld(&bar[XB_TOPGEN]) == tg, bar);
            __builtin_amdgcn_fence(__ATOMIC_ACQUIRE, "agent");
            xb_add(&bar[XB_XGEN(b.x)], 1u);
            asm volatile("s_waitcnt vmcnt(0)" ::: "memory");
        } else {
            XB_SPIN(xb_ld(&bar[XB_XGEN(b.x)]) == gen, bar);
            __builtin_amdgcn_fence(__ATOMIC_ACQUIRE, "agent");
            asm volatile("s_waitcnt vmcnt(0)" ::: "memory");
        }
    }
    __syncthreads();
}

#define WSB(off) (opaque_ptr(P.ws) + (off))
__global__ void __launch_bounds__(512, 2) mega_fwd(Params P) {
    extern __shared__ __attribute__((aligned(16))) unsigned char lds_raw[];
    LAS unsigned char* lds = (LAS unsigned char*)lds_raw;
    const int wave = __builtin_amdgcn_readfirstlane((int)threadIdx.x >> 6);
    const int G = gridDim.x, bx = blockIdx.x;
    const int vcu = (G % 8 == 0) ? (bx % 8) * (G / 8) + bx / 8 : bx;
    const int gw = vcu * 8 + wave, NGW = G * 8;
    LAS float* scr = (LAS float*)(lds + wave * 16384);
    volatile LAS unsigned* misc = (volatile LAS unsigned*)(lds + LDS_MISC);
    if (threadIdx.x < 2) misc[threadIdx.x] = 0u;
    __syncthreads();
    const XcdBarrier bar = xcd_barrier_post((unsigned*)(P.ws + WS_BAR), misc);

    convert_layer(P, 0, scr, gw, NGW, opaque_lane());
    rowpass0(gw, NGW, opaque_lane(), P.x, (bf16_t*)WSB(WS_HB), (float*)WSB(WS_RSTD));
    cg::this_grid().sync();

#pragma unroll 1
    for (int layer = 0; layer < 4; ++layer) {
        const float* g = P.norm_g + (size_t)layer * 4 * D;
        if (layer < 2) {
            {
                unsigned char* ws = WSB(0);
                pg8::Gemm gm{(bf16_t*)(ws + WS_HB), (bf16_t*)(ws + WS_WA), M, D, D}; pg8::StaticOrder S; S.init(M, D, G, bx);
                pg8::EpiRow<1> E{(bf16_t*)(ws + WS_U), nullptr, D, 1 << 20, (float*)(ws + WS_RSTD), 1.0f};
                pg8::gemm_phase<pg8::EpiRow<1>, pg8::StaticOrder, true, true>(lds, gm, S, E, wave);
            }
            {
                unsigned char* ws = WSB(0);
                pg8::Gemm gm{(bf16_t*)(ws + WS_WA) + (size_t)D * D, (bf16_t*)(ws + WS_HB), D, M, D}; pg8::StaticOrder S; S.init(D, M, G, bx);
                pg8::EpiCol<0> E{(bf16_t*)(ws + WS_VT), M, (float*)(ws + WS_RSTD), (float*)(ws + WS_LNS), (float*)(ws + WS_LNQ)};
                pg8::gemm_phase<pg8::EpiCol<0>, pg8::StaticOrder, true, true>(lds, gm, S, E, wave);
            }
        } else {
            {
                unsigned char* ws = WSB(0);
                const int N = layer == 2 ? 2 * D : D;
                pg8::Gemm gm{(bf16_t*)(ws + WS_HB), (bf16_t*)(ws + WS_WA), M, N, D}; pg8::StaticOrder S; S.init(M, N, G, bx);
                pg8::EpiRow<0> E{(bf16_t*)(ws + WS_Q), (bf16_t*)(ws + WS_K), D, 4, (float*)(ws + WS_RSTD), QSCALE};
                pg8::gemm_phase<pg8::EpiRow<0>, pg8::StaticOrder, true, true>(lds, gm, S, E, wave);
            }
            if (layer == 2) {
                unsigned char* ws = WSB(0);
                pg8::Gemm gm{(bf16_t*)(ws + WS_WA) + (size_t)2 * D * D, (bf16_t*)(ws + WS_HB), D, M, D}; pg8::StaticOrder S; S.init(D, M, G, bx);
                pg8::EpiCol<1> E{(bf16_t*)(ws + WS_VTA), M, (float*)(ws + WS_RSTD), nullptr, nullptr};
                pg8::gemm_phase<pg8::EpiCol<1>, pg8::StaticOrder, true, true>(lds, gm, S, E, wave);
            }
        }
        xcd_barrier(bar);
        if (layer < 2) {
            unsigned char* ws = WSB(0);
            gate_phase(lds, vcu, G, (const bf16_t*)(ws + WS_U), (const bf16_t*)(ws + WS_VT), (const float*)(ws + WS_LNS), (const float*)(ws + WS_LNQ), P.a_ln_g + layer * D, P.a_ln_b + layer * D,
                       P.a_w_s + (size_t)layer * 8 * 128 * 128, P.a_b_s + layer * 8 * 128, (bf16_t*)(ws + WS_UG), wave);
        } else {
            unsigned char* ws = WSB(0);
            attn_phase(lds, vcu, G, (const bf16_t*)(ws + WS_Q), (const bf16_t*)(ws + WS_K), (const bf16_t*)(ws + WS_VTA), P.b_rel + (size_t)(layer - 2) * NH * 513, (bf16_t*)(ws + WS_O), wave);
        }
        xcd_barrier(bar);
        {
            unsigned char* ws = WSB(0);
            pg8::Gemm gm{layer < 2 ? (const bf16_t*)(ws + WS_UG) : (const bf16_t*)(ws + WS_O), (bf16_t*)(ws + WS_WB), M, D, D}; pg8::StaticOrder S; S.init(M, D, G, bx);
            pg8::EpiSq E{(bf16_t*)(ws + WS_U), D, (float*)(ws + WS_PSQ)};
            pg8::gemm_phase<pg8::EpiSq, pg8::StaticOrder, true, true>(lds, gm, S, E, wave);
        }
        xcd_barrier(bar);
        { unsigned char* ws = WSB(0); rowpass(gw, NGW, opaque_lane(), (bf16_t*)(ws + WS_HB), (const bf16_t*)(ws + WS_U), (const float*)(ws + WS_PSQ), g + D, (float*)(ws + WS_RSTD), nullptr); }
        xcd_barrier(bar);
        {
            unsigned char* ws = WSB(0);
            pg8::Gemm gm{(bf16_t*)(ws + WS_HB), (bf16_t*)(ws + WS_WUP), M, FF, D}; pg8::StaticOrder S; S.init(M, FF, G, bx);
            pg8::EpiRow<2> E{(bf16_t*)(ws + WS_T), nullptr, FF, 1 << 20, (float*)(ws + WS_RSTD), 1.0f};
            pg8::gemm_phase<pg8::EpiRow<2>, pg8::StaticOrder, true, true>(lds, gm, S, E, wave);
        }
        xcd_barrier(bar);
        {
            unsigned char* ws = WSB(0);
            pg8::Gemm gm{(bf16_t*)(ws + WS_T), (bf16_t*)(ws + WS_WDN), M, D, FF}; pg8::StaticOrder S; S.init(M, D, G, bx);
            pg8::EpiSq E{layer < 3 ? (bf16_t*)opaque_ptr(P.out) : (bf16_t*)(ws + WS_K), D, (float*)(ws + WS_PSQ)};
            pg8::gemm_phase<pg8::EpiSq, pg8::StaticOrder, true, true>(lds, gm, S, E, wave);
        }
        xcd_barrier(bar);
        { unsigned char* ws = WSB(0); rowpass(gw, NGW, opaque_lane(), (bf16_t*)(ws + WS_HB), layer < 3 ? (const bf16_t*)opaque_ptr(P.out) : (const bf16_t*)(ws + WS_K), (const float*)(ws + WS_PSQ), g + 3 * D, (float*)(ws + WS_RSTD), layer < 3 ? nullptr : P.out); }
        if (layer < 3) { convert_layer(P, layer + 1, scr, gw, NGW, opaque_lane()); xcd_barrier(bar); }
    }
}

extern "C" void kernel_launch(void* const* d_in, const int* in_sizes, int n_in, void* d_out, int out_size, void* d_ws, size_t ws_size, hipStream_t stream) {
    static int grid = 0;
    if (grid == 0) {
        if (n_in != 16 || out_size != M * D || ws_size < WS_END) { fprintf(stderr, "kernel_launch: unexpected shapes: n_in %d out %d ws %zu\n", n_in, out_size, ws_size); grid = -1; return; }
        int dev = 0, cus = 0, per_cu = 0;
        if (hipGetDevice(&dev) != hipSuccess || hipDeviceGetAttribute(&cus, hipDeviceAttributeMultiprocessorCount, dev) != hipSuccess) { grid = -1; return; }
        if (hipFuncSetAttribute((const void*)mega_fwd, hipFuncAttributeMaxDynamicSharedMemorySize, LDS_BYTES) != hipSuccess) { fprintf(stderr, "kernel_launch: hipFuncSetAttribute failed\n"); grid = -1; return; }
        if (hipOccupancyMaxActiveBlocksPerMultiprocessor(&per_cu, (const void*)mega_fwd, 512, LDS_BYTES) != hipSuccess || per_cu < 1) { fprintf(stderr, "kernel_launch: occupancy query failed (%d)\n", per_cu); grid = -1; return; }
        grid = cus * per_cu;
        fprintf(stderr, "kernel_launch: grid %d (%d CUs x %d)\n", grid, cus, per_cu);
    }
    if (grid < 0) return;
    Params p{};
    p.x = (const float*)d_in[0]; p.norm_g = (const float*)d_in[1]; p.a_w_in = (const float*)d_in[2]; p.a_ln_g = (const float*)d_in[3]; p.a_ln_b = (const float*)d_in[4];
    p.a_w_s = (const float*)d_in[5]; p.a_b_s = (const float*)d_in[6]; p.a_w_out = (const float*)d_in[7]; p.kv_norm_g = (const float*)d_in[8]; p.w_k = (const float*)d_in[9];
    p.w_v = (const float*)d_in[10]; p.b_w_q = (const float*)d_in[11]; p.b_rel = (const float*)d_in[12]; p.b_w_o = (const float*)d_in[13]; p.w_up = (const float*)d_in[14]; p.w_down = (const float*)d_in[15];
    p.out = (float*)d_out; p.ws = (unsigned char*)d_ws;
    if (hipMemsetAsync((char*)d_ws + WS_BAR, 0, BAR_ZERO_BYTES, stream) != hipSuccess) { fprintf(stderr, "kernel_launch: memset failed\n"); return; }
    void* args[] = {&p};
    const hipError_t e = hipLaunchCooperativeKernel((const void*)mega_fwd, dim3(grid), dim3(512), args, LDS_BYTES, stream);
    if (e != hipSuccess) fprintf(stderr, "kernel_launch: cooperative launch failed: %s (grid %d)\n", hipGetErrorString(e), grid);
}
```

```cpp
#include <hip/hip_runtime.h>
#include <hip/hip_cooperative_groups.h>
#include <cstdio>
#include <cstdint>
namespace cg = cooperative_groups;
__device__ __forceinline__ int opaque_lane() { int l = __builtin_amdgcn_mbcnt_hi(~0u, __builtin_amdgcn_mbcnt_lo(~0u, 0u)); asm volatile("" : "+v"(l)); return l; }
template <class T> __device__ __forceinline__ T* opaque_ptr(T* p) { asm volatile("" : "+s"(p)); return p; }
namespace pg8 {
#define PG8_LAS __attribute__((address_space(3)))
typedef unsigned short bf16_t;
typedef short bf16x8 __attribute__((ext_vector_type(8)));
typedef float f32x4 __attribute__((ext_vector_type(4)));
typedef unsigned u32x4 __attribute__((ext_vector_type(4)));
constexpr int BM = 256, BK = 64, HALF = 128, HTB = HALF * BK * 2  , STAGE_BYTES = 8 * HTB, NXCD = 8, WGM = 8;

__host__ __device__ __forceinline__ int lds_byte(int r, int c) { const int st = (r >> 4) * 2 + (c >> 5), rr = r & 15, cc = c & 31, ob = rr * 64 + cc * 2; return st * 1024 + (ob ^ (((ob >> 9) & 1) << 5)); }
__host__ __device__ __forceinline__ void stage_rc(int b, int& R, int& C) { const int st = b / 1024, sb = b % 1024, swz = sb ^ (((sb >> 9) & 1) << 5); R = (st >> 1) * 16 + swz / 64; C = (st & 1) * 32 + (swz % 64) / 2; }
__host__ __device__ __forceinline__ int perm32(int rho) { const int n = rho >> 4, i = rho & 15; return 8 * (i >> 2) + 4 * n + (i & 3); }

struct Unit { int pm, pn; };
struct Gemm { const bf16_t* A; const bf16_t* Bt; int M, N, K; };

struct StaticOrder {
    int nM, nN, nwg, G, c;
    __host__ __device__ void init(int M, int N, int G_, int c_) { nM = M / BM; nN = N / BM; nwg = nM * nN; G = G_; c = c_; }
    __host__ __device__ bool next(int i, Unit& u) const {
        const long L = (long)i * G + c; if (L >= nwg) return false;
        int wgid = (int)L; { const int q = nwg / NXCD, r = nwg % NXCD, xcd = wgid % NXCD, off = wgid / NXCD; wgid = (xcd < r ? xcd * (q + 1) : r * (q + 1) + (xcd - r) * q) + off; }
        const int nig = WGM * nN, gid = wgid / nig, fm = gid * WGM, gsz = (nM - fm) < WGM ? (nM - fm) : WGM;
        u.pm = fm + ((wgid % nig) % gsz); u.pn = (wgid % nig) / gsz; return true;
    }
    __device__ __forceinline__ void a_ready(const Unit&) const {}
    __device__ __forceinline__ void done(const Unit&) const {}
};

__device__ __forceinline__ unsigned cvt_pk_bf16(float lo, float hi) { unsigned r; asm volatile("v_cvt_pk_bf16_f32 %0, %1, %2" : "=v"(r) : "v"(lo), "v"(hi)); return r; }
typedef float f32x2 __attribute__((ext_vector_type(2)));
typedef unsigned u32x2 __attribute__((ext_vector_type(2)));
__device__ __forceinline__ float gelu_tanh_f(float x) {
    const float u = x * (0.7978845608f + 0.0356774081f * x * x);
    const float e = __builtin_amdgcn_exp2f(-2.885390082f * u);
    return x * __builtin_amdgcn_rcpf(1.0f + e);
}
template <int ACT> __device__ __forceinline__ f32x4 act4(f32x4 v) {
    if (ACT == 1) { v[0] = gelu_tanh_f(v[0]); v[1] = gelu_tanh_f(v[1]); v[2] = gelu_tanh_f(v[2]); v[3] = gelu_tanh_f(v[3]); }
    if (ACT == 2) { v[0] = fmaxf(v[0], 0.f); v[1] = fmaxf(v[1], 0.f); v[2] = fmaxf(v[2], 0.f); v[3] = fmaxf(v[3], 0.f); v = v * v; }
    return v;
}
template <int ACT> struct EpiRow {
    static constexpr bool PERM = true, AFTER_DRAIN = false;
    bf16_t* O; bf16_t* O2; int ldc; int split_pn; const float* rs; float scale0;
    __device__ __forceinline__ void operator()(const f32x4 (&acc)[2][2][4][2], const Unit& u, int wr, int wc, int fr, int fq) const {
        const int row0 = u.pm * BM + wr * 64 + fr;
        bf16_t* base = O; int colt = u.pn * BM; float sc = scale0;
        bool ksplit = false;
        if (u.pn >= split_pn) { base = O2; colt -= split_pn * BM; sc = 1.f; ksplit = true; }
        const int col0 = colt + wc * 32 + 8 * fq;
#pragma unroll
        for (int ai = 0; ai < 2; ++ai)
#pragma unroll
            for (int m = 0; m < 4; ++m) {
                const int row = row0 + ai * HALF + m * 16;
                const float r = rs[row] * sc;
                bf16_t* rowp = base + (size_t)row * ldc + col0;
#pragma unroll
                for (int bj = 0; bj < 2; ++bj) {
                    const f32x4 v0 = act4<ACT>(acc[ai][bj][m][0] * r), v1 = act4<ACT>(acc[ai][bj][m][1] * r);
                    u32x4 w; w.x = cvt_pk_bf16(v0[0], v0[1]); w.y = cvt_pk_bf16(v0[2], v0[3]); w.z = cvt_pk_bf16(v1[0], v1[1]); w.w = cvt_pk_bf16(v1[2], v1[3]);
                    if (ksplit) {
                        const int ck = col0 + bj * HALF, hh = ck >> 6, ch = (ck >> 3) & 7;
                        *(u32x4*)(base + ((size_t)(row >> 5) * 16 + hh) * 2048 + (ch * 32 + (row & 31)) * 8) = w;
                    } else *(u32x4*)(rowp + bj * HALF) = w;
                }
            }
    }
};
template <int MODE> struct EpiCol {
    static constexpr bool PERM = true, AFTER_DRAIN = false;
    bf16_t* O; int ldc; const float* cs; float* psum; float* psq;
    __device__ __forceinline__ void operator()(const f32x4 (&acc)[2][2][4][2], const Unit& u, int wr, int wc, int fr, int fq) const {
        const int row0 = u.pm * BM + wr * 64 + fr, col0 = u.pn * BM + wc * 32 + 8 * fq;
        f32x4 sv[2][2], s1[2][2], s2[2][2];
#pragma unroll
        for (int bj = 0; bj < 2; ++bj)
#pragma unroll
            for (int n = 0; n < 2; ++n) { sv[bj][n] = *(const f32x4*)(cs + col0 + bj * HALF + 4 * n); s1[bj][n] = (f32x4){0.f, 0.f, 0.f, 0.f}; s2[bj][n] = (f32x4){0.f, 0.f, 0.f, 0.f}; }
#pragma unroll
        for (int ai = 0; ai < 2; ++ai)
#pragma unroll
            for (int m = 0; m < 4; ++m) {
                bf16_t* rowp = O + (size_t)(row0 + ai * HALF + m * 16) * ldc;
#pragma unroll
                for (int bj = 0; bj < 2; ++bj) {
                    if (MODE == 0) {
                        const f32x4 v0 = act4<1>(acc[ai][bj][m][0] * sv[bj][0]), v1 = act4<1>(acc[ai][bj][m][1] * sv[bj][1]);
                        s1[bj][0] += v0; s2[bj][0] += v0 * v0; s1[bj][1] += v1; s2[bj][1] += v1 * v1;
                        u32x4 w; w.x = cvt_pk_bf16(v0[0], v0[1]); w.y = cvt_pk_bf16(v0[2], v0[3]); w.z = cvt_pk_bf16(v1[0], v1[1]); w.w = cvt_pk_bf16(v1[2], v1[3]);
                        *(u32x4*)(rowp + col0 + bj * HALF) = w;
                    } else {
                        const f32x4 v0 = acc[ai][bj][m][0] * sv[bj][0], v1 = acc[ai][bj][m][1] * sv[bj][1];
                        const int chn = row0 + ai * HALF + m * 16, hh = chn >> 6, dd = chn & 63;
                        const int t32 = (u.pn * BM + bj * HALF + wc * 32) >> 5, s2 = fq >> 1;
                        bf16_t* blk = O + ((size_t)t32 * 16 + hh) * 2048 + ((((dd >> 5) * 2 + s2) * 2) * 32 + (dd & 31)) * 8 + 4 * (fq & 1);
                        u32x2 a, b; a.x = cvt_pk_bf16(v0[0], v0[1]); a.y = cvt_pk_bf16(v0[2], v0[3]); b.x = cvt_pk_bf16(v1[0], v1[1]); b.y = cvt_pk_bf16(v1[2], v1[3]);
                        *(u32x2*)(blk) = a; *(u32x2*)(blk + 256) = b;
                    }
                }
            }
        if (MODE == 0) {
#pragma unroll
            for (int bj = 0; bj < 2; ++bj)
#pragma unroll
                for (int n = 0; n < 2; ++n) {
#pragma unroll
                    for (int e = 0; e < 4; ++e) {
                        float a = s1[bj][n][e], b = s2[bj][n][e];
                        a += __shfl_xor(a, 1); b += __shfl_xor(b, 1); a += __shfl_xor(a, 2); b += __shfl_xor(b, 2);
                        a += __shfl_xor(a, 4); b += __shfl_xor(b, 4); a += __shfl_xor(a, 8); b += __shfl_xor(b, 8);
                        s1[bj][n][e] = a; s2[bj][n][e] = b;
                    }
                    if (fr == 0) {
                        const size_t po = (size_t)(u.pm * 2 + wr) * ldc + col0 + bj * HALF + 4 * n;
                        *(f32x4*)(psum + po) = s1[bj][n]; *(f32x4*)(psq + po) = s2[bj][n];
                    }
                }
        }
    }
};
struct EpiSq {
    static constexpr bool PERM = true, AFTER_DRAIN = false;
    bf16_t* O; int ldc; float* psq;
    __device__ __forceinline__ void operator()(const f32x4 (&acc)[2][2][4][2], const Unit& u, int wr, int wc, int fr, int fq) const {
        const int row0 = u.pm * BM + wr * 64 + fr, col0 = u.pn * BM + wc * 32 + 8 * fq;
#pragma unroll
        for (int ai = 0; ai < 2; ++ai)
#pragma unroll
            for (int m = 0; m < 4; ++m) {
                const int row = row0 + ai * HALF + m * 16;
                bf16_t* rowp = O + (size_t)row * ldc + col0;
                float s = 0.f;
#pragma unroll
                for (int bj = 0; bj < 2; ++bj) {
                    const f32x4 v0 = acc[ai][bj][m][0], v1 = acc[ai][bj][m][1];
                    s += (v0[0] * v0[0] + v0[1] * v0[1]) + (v0[2] * v0[2] + v0[3] * v0[3]) + (v1[0] * v1[0] + v1[1] * v1[1]) + (v1[2] * v1[2] + v1[3] * v1[3]);
                    u32x4 w; w.x = cvt_pk_bf16(v0[0], v0[1]); w.y = cvt_pk_bf16(v0[2], v0[3]); w.z = cvt_pk_bf16(v1[0], v1[1]); w.w = cvt_pk_bf16(v1[2], v1[3]);
                    *(u32x4*)(rowp + bj * HALF) = w;
                }
                s += __shfl_xor(s, 16); s += __shfl_xor(s, 32);
                if (fq == 0) psq[(size_t)row * 16 + u.pn * 4 + wc] = s;
            }
    }
};
template <class Epi, class Sched, bool ALIGN_EPI = false, bool SP2 = false>
__device__ __forceinline__ void gemm_phase(PG8_LAS unsigned char* lds, const Gemm g, const Sched& S, const Epi& E, const int wid) {
    const int lane = opaque_lane(), tid = wid * 64 + lane, wr = wid >> 2, wc = wid & 3, fr = lane & 15, fq = lane >> 4;
    const int K = g.K, nt = K / BK;
    unsigned voffA[2], voffB[2];
#pragma unroll
    for (int i = 0; i < 2; ++i) { int R, C; stage_rc(tid * 16 + i * 8192, R, C); const int Rb = Epi::PERM ? ((R & ~31) + perm32(R & 31)) : R;
        voffA[i] = (unsigned)(R * K + C) * 2u; voffB[i] = (unsigned)(Rb * K + C) * 2u; }
    const size_t kstep = (size_t)(BK * 2);
    const size_t hstep = (size_t)HALF * K * 2;
    const size_t tstep = 2 * hstep;
    const unsigned ldsw = (unsigned)wid * 1024u;
    const int aoff = lds_byte(wr * 64 + fr, fq * 8), boff = lds_byte(wc * 32 + fr, fq * 8);
#define PG8_SA(b, h) (((b) * 2 + (h)) * HTB)
#define PG8_SB(b, h) ((4 + (b) * 2 + (h)) * HTB)
#define PG8_STAGE(bufoff, gbase, voff) do { _Pragma("unroll") for (int _i = 0; _i < 2; ++_i) \
        __builtin_amdgcn_global_load_lds((const unsigned*)((const char*)(gbase) + (voff)[_i]), (PG8_LAS unsigned*)(lds + (bufoff) + ldsw + _i * 8192), 16, 0, 0); } while (0)
#define PG8_LDA(dst, b, h) do { _Pragma("unroll") for (int m = 0; m < 4; ++m) _Pragma("unroll") for (int k = 0; k < 2; ++k) dst[m][k] = *(const PG8_LAS bf16x8*)(lds + PG8_SA(b, h) + aoff + m * 2048 + k * 1024); } while (0)
#define PG8_LDB(dst, b, h) do { _Pragma("unroll") for (int n = 0; n < 2; ++n) _Pragma("unroll") for (int k = 0; k < 2; ++k) dst[n][k] = *(const PG8_LAS bf16x8*)(lds + PG8_SB(b, h) + boff + n * 2048 + k * 1024); } while (0)
#define PG8_MMA(ai, bj, At, Bt) do { __builtin_amdgcn_s_setprio(1); _Pragma("unroll") for (int m = 0; m < 4; ++m) _Pragma("unroll") for (int n = 0; n < 2; ++n) _Pragma("unroll") for (int k = 0; k < 2; ++k) \
        acc[ai][bj][m][n] = __builtin_amdgcn_mfma_f32_16x16x32_bf16(Bt[n][k], At[m][k], acc[ai][bj][m][n], 0, 0, 0); __builtin_amdgcn_s_setprio(0); } while (0)
#define PG8_WAIT_V(n) asm volatile("s_waitcnt vmcnt(" #n ")" ::: "memory")
#define PG8_WAIT_L(n) asm volatile("s_waitcnt lgkmcnt(" #n ")" ::: "memory")
#define PG8_BAR __builtin_amdgcn_s_barrier()
#define PG8_SCHED __builtin_amdgcn_sched_barrier(0)
    Unit cur, nxt; int ui = 0;
    if (!S.next(0, cur)) return;
    f32x4 acc[2][2][4][2];
#pragma unroll
    for (int a = 0; a < 2; ++a)
#pragma unroll
        for (int b = 0; b < 2; ++b)
#pragma unroll
            for (int m = 0; m < 4; ++m)
#pragma unroll
                for (int n = 0; n < 2; ++n) acc[a][b][m][n] = (f32x4){0.f, 0.f, 0.f, 0.f};
    bf16x8 At[4][2], B0[2][2], B1[2][2];
    const char* cA = (const char*)g.A + (size_t)cur.pm * tstep; const char* cB = (const char*)g.Bt + (size_t)cur.pn * tstep;
    S.a_ready(cur);
    if constexpr (SP2) {
        PG8_STAGE(PG8_SB(0, 0), cB, voffB); PG8_STAGE(PG8_SB(0, 1), cB + hstep, voffB); PG8_STAGE(PG8_SA(0, 0), cA, voffA); PG8_STAGE(PG8_SA(0, 1), cA + hstep, voffA);
        if (wr == 1) PG8_BAR;
        PG8_WAIT_V(2); PG8_BAR;
        PG8_STAGE(PG8_SB(1, 0), cB + kstep, voffB); PG8_STAGE(PG8_SA(1, 0), cA + kstep, voffA); PG8_STAGE(PG8_SB(1, 1), cB + hstep + kstep, voffB);
        PG8_WAIT_V(6); PG8_BAR;
    } else {
        PG8_STAGE(PG8_SB(0, 0), cB, voffB); PG8_STAGE(PG8_SA(0, 0), cA, voffA); PG8_STAGE(PG8_SB(0, 1), cB + hstep, voffB); PG8_STAGE(PG8_SA(0, 1), cA + hstep, voffA);
        if (wr == 1) PG8_BAR;
        PG8_WAIT_V(4); PG8_BAR;
        PG8_STAGE(PG8_SB(1, 0), cB + kstep, voffB); PG8_STAGE(PG8_SA(1, 0), cA + kstep, voffA); PG8_STAGE(PG8_SB(1, 1), cB + hstep + kstep, voffB);
        PG8_WAIT_V(6); PG8_BAR;
    }
    for (;;) {
        const bool has_next = S.next(ui + 1, nxt);
        const char* nA = has_next ? (const char*)g.A + (size_t)nxt.pm * tstep : cA; const char* nB = has_next ? (const char*)g.Bt + (size_t)nxt.pn * tstep : cB;
        for (int t = 0; t < nt; t += 2) {
            const bool last = (t == nt - 2);
            const char* a1 = cA + (size_t)(t + 1) * kstep;
            const char* a2 = last ? nA : cA + (size_t)(t + 2) * kstep; const char* b2 = last ? nB : cB + (size_t)(t + 2) * kstep;
            const char* a3 = a2 + kstep; const char* b3 = b2 + kstep;
            if (last && has_next) S.a_ready(nxt);
            if constexpr (SP2) {
            PG8_LDB(B0, 0, 0); PG8_LDB(B1, 0, 1); PG8_SCHED; PG8_LDA(At, 0, 0); PG8_STAGE(PG8_SA(1, 1), a1 + hstep, voffA);
            PG8_WAIT_V(8); PG8_WAIT_L(0); PG8_BAR; PG8_MMA(0, 0, At, B0); PG8_MMA(0, 1, At, B1); PG8_BAR; PG8_SCHED;
            PG8_LDA(At, 0, 1); PG8_STAGE(PG8_SB(0, 0), b2, voffB); PG8_STAGE(PG8_SB(0, 1), b2 + hstep, voffB); PG8_STAGE(PG8_SA(0, 0), a2, voffA);
            PG8_WAIT_V(8); PG8_WAIT_L(0); PG8_BAR; PG8_MMA(1, 0, At, B0); PG8_MMA(1, 1, At, B1); PG8_BAR; PG8_SCHED;
            PG8_LDB(B0, 1, 0); PG8_LDB(B1, 1, 1); PG8_SCHED; PG8_LDA(At, 1, 0); PG8_STAGE(PG8_SA(0, 1), a2 + hstep, voffA);
            PG8_WAIT_V(8); PG8_WAIT_L(0); PG8_BAR; PG8_MMA(0, 0, At, B0); PG8_MMA(0, 1, At, B1); PG8_BAR; PG8_SCHED;
            PG8_LDA(At, 1, 1); PG8_STAGE(PG8_SB(1, 0), b3, voffB); PG8_STAGE(PG8_SB(1, 1), b3 + hstep, voffB); PG8_STAGE(PG8_SA(1, 0), a3, voffA);
            PG8_WAIT_V(8); PG8_WAIT_L(0); PG8_BAR; PG8_MMA(1, 0, At, B0); PG8_MMA(1, 1, At, B1); PG8_BAR; PG8_SCHED;
            } else {
            PG8_LDB(B0, 0, 0); PG8_SCHED; PG8_LDA(At, 0, 0); PG8_STAGE(PG8_SA(1, 1), a1 + hstep, voffA);
            PG8_WAIT_L(8); PG8_BAR; PG8_WAIT_L(0); PG8_MMA(0, 0, At, B0); PG8_BAR; PG8_SCHED;
            PG8_LDB(B1, 0, 1); PG8_STAGE(PG8_SB(0, 0), b2, voffB);
            PG8_BAR; PG8_WAIT_L(0); PG8_MMA(0, 1, At, B1); PG8_BAR;
            PG8_LDA(At, 0, 1); PG8_STAGE(PG8_SA(0, 0), a2, voffA);
            PG8_BAR; PG8_WAIT_L(0); PG8_MMA(1, 0, At, B0); PG8_BAR; PG8_SCHED;
            PG8_STAGE(PG8_SB(0, 1), b2 + hstep, voffB);
            PG8_WAIT_V(6); PG8_BAR; PG8_MMA(1, 1, At, B1); PG8_BAR;
            PG8_LDB(B0, 1, 0); PG8_SCHED; PG8_LDA(At, 1, 0); PG8_STAGE(PG8_SA(0, 1), a2 + hstep, voffA);
            PG8_WAIT_L(8); PG8_BAR; PG8_WAIT_L(0); PG8_MMA(0, 0, At, B0); PG8_BAR; PG8_SCHED;
            PG8_LDB(B1, 1, 1); PG8_STAGE(PG8_SB(1, 0), b3, voffB);
            PG8_BAR; PG8_WAIT_L(0); PG8_MMA(0, 1, At, B1); PG8_BAR;
            PG8_LDA(At, 1, 1); PG8_STAGE(PG8_SA(1, 0), a3, voffA);
            PG8_BAR; PG8_WAIT_L(0); PG8_MMA(1, 0, At, B0); PG8_BAR; PG8_SCHED;
            PG8_STAGE(PG8_SB(1, 1), b3 + hstep, voffB);
            PG8_WAIT_V(6); PG8_BAR; PG8_MMA(1, 1, At, B1); PG8_BAR;
            }
        }
        if constexpr (ALIGN_EPI) { if (wr == 0) PG8_BAR; }
        if constexpr (!Epi::AFTER_DRAIN) { E(acc, cur, wr, wc, fr, fq); S.done(cur); }
        if (!has_next) break;
#pragma unroll
        for (int a = 0; a < 2; ++a)
#pragma unroll
            for (int b = 0; b < 2; ++b)
#pragma unroll
                for (int m = 0; m < 4; ++m)
#pragma unroll
                    for (int n = 0; n < 2; ++n) acc[a][b][m][n] = (f32x4){0.f, 0.f, 0.f, 0.f};
        cur = nxt; cA = nA; cB = nB; ++ui;
        if constexpr (ALIGN_EPI) { if (wr == 1) PG8_BAR; }
    }
    PG8_WAIT_V(0);
    if constexpr (!ALIGN_EPI) { if (wr == 0) PG8_BAR; }
    PG8_BAR;
    if constexpr (Epi::AFTER_DRAIN) { E.fused(acc, cur, wr, wc, fr, fq, lds, wid, lane); S.done(cur); }
#undef PG8_SA
#undef PG8_SB
#undef PG8_STAGE
#undef PG8_LDA
#undef PG8_LDB
#undef PG8_MMA
#undef PG8_WAIT_V
#undef PG8_WAIT_L
#undef PG8_BAR
#undef PG8_SCHED
}
}

#define LAS __attribute__((address_space(3)))
typedef unsigned short bf16_t;
typedef float f32x4 __attribute__((ext_vector_type(4)));
typedef float f32x16 __attribute__((ext_vector_type(16)));
typedef unsigned u32x4 __attribute__((ext_vector_type(4)));
typedef unsigned u32x2 __attribute__((ext_vector_type(2)));
typedef short bf16x8 __attribute__((ext_vector_type(8)));
constexpr int D = 1024, SEQ = 4096, NBATCH = 4, M = NBATCH * SEQ, FF = 4096, NH = 16;
constexpr size_t MiB = 1u << 20;
constexpr size_t WS_RSTD = 0, WS_PSQ = 1 * MiB, WS_LNS = 2 * MiB, WS_LNQ = 2 * MiB + 512 * 1024;
constexpr size_t WS_WA = 4 * MiB, WS_WB = 10 * MiB, WS_WUP = 12 * MiB, WS_WDN = 20 * MiB;
constexpr size_t WS_HB = 28 * MiB, WS_T = 60 * MiB, WS_U = 60 * MiB, WS_VT = 92 * MiB, WS_UG = 124 * MiB, WS_Q = 60 * MiB, WS_O = 92 * MiB;
constexpr size_t WS_K = 188 * MiB, WS_VTA = 220 * MiB, WS_END = 252 * MiB;
constexpr size_t WS_BAR = 3 * MiB, BAR_ZERO_BYTES = 16384;
constexpr int LDS_BYTES = 147456, LDS_MISC = 131072 + 512;
constexpr float LOG2E = 1.4426950408889634f;
constexpr float QSCALE = 0.125f * LOG2E;

__device__ __forceinline__ float wave_sum(float v) {
#pragma unroll
    for (int o = 1; o < 64; o <<= 1) v += __shfl_xor(v, o);
    return v;
}
__device__ __forceinline__ unsigned pk2(float lo, float hi) { return pg8::cvt_pk_bf16(lo, hi); }
__device__ __forceinline__ float bflo(unsigned w) { return __uint_as_float(w << 16); }
__device__ __forceinline__ float bfhi(unsigned w) { return __uint_as_float(w & 0xffff0000u); }

__device__ __forceinline__ void transpose_item(const float* W, const float* gain, int K, int N, bf16_t* WT, LAS float* scr, int item, int lane) {
    const int nblk = N / 32, kb = item / nblk, nb = item % nblk, k0 = 64 * kb, n0 = 32 * nb;
    const int kr = lane >> 3, nc = lane & 7;
    f32x4 w[8];
#pragma unroll
    for (int i = 0; i < 8; ++i) w[i] = *(const f32x4*)(W + (size_t)(k0 + 8 * i + kr) * N + n0 + 4 * nc);
    if (gain) {
#pragma unroll
        for (int i = 0; i < 8; ++i) w[i] = w[i] * gain[k0 + 8 * i + kr];
    }
#pragma unroll
    for (int i = 0; i < 8; ++i) { LAS float* d = scr + (8 * i + kr) * 33 + 4 * nc; d[0] = w[i][0]; d[1] = w[i][1]; d[2] = w[i][2]; d[3] = w[i][3]; }
    asm volatile("s_waitcnt lgkmcnt(0)" ::: "memory");
    const int c = lane & 7;
#pragma unroll
    for (int j = 0; j < 4; ++j) { const int n = (lane >> 3) + 8 * j; const LAS float* s = scr + (8 * c) * 33 + n;
        u32x4 o; o.x = pk2(s[0 * 33], s[1 * 33]); o.y = pk2(s[2 * 33], s[3 * 33]); o.z = pk2(s[4 * 33], s[5 * 33]); o.w = pk2(s[6 * 33], s[7 * 33]);
        *(u32x4*)(WT + (size_t)(n0 + n) * K + k0 + 8 * c) = o; }
    asm volatile("s_waitcnt lgkmcnt(0)" ::: "memory");
}
__device__ __forceinline__ void convert_job(const float* W, const float* gain, int K, int N, bf16_t* WT, int off, LAS float* scr, int gw, int NGW, int lane) {
    const int nitems = (K / 64) * (N / 32);
    int it0 = gw - off; if (it0 < 0) it0 += NGW;
    for (int it = it0; it < nitems; it += NGW) transpose_item(W, gain, K, N, WT, scr, it, lane);
}

struct Params {
    const float *x, *norm_g, *a_w_in, *a_ln_g, *a_ln_b, *a_w_s, *a_b_s, *a_w_out, *kv_norm_g, *w_k, *w_v, *b_w_q, *b_rel, *b_w_o, *w_up, *w_down;
    float* out; unsigned char* ws;
};

__device__ __forceinline__ void convert_layer(const Params& P, int layer, LAS float* scr, int gw, int NGW, int lane) {
    unsigned char* ws = opaque_ptr(P.ws);
    const float* g = P.norm_g + (size_t)layer * 4 * D;
    const int q1 = NGW / 4;
    if (layer < 2) {
        convert_job(P.a_w_in + (size_t)layer * D * 2048, g, D, 2048, (bf16_t*)(ws + WS_WA), 0, scr, gw, NGW, lane);
        convert_job(P.a_w_out + (size_t)layer * D * D, nullptr, D, D, (bf16_t*)(ws + WS_WB), 2 * q1, scr, gw, NGW, lane);
    } else {
        const int j = layer - 2;
        convert_job(P.b_w_q + (size_t)j * D * D, g, D, D, (bf16_t*)(ws + WS_WA), 0, scr, gw, NGW, lane);
        if (layer == 2) {
            convert_job(P.w_k, P.kv_norm_g, D, D, (bf16_t*)(ws + WS_WA) + (size_t)D * D, q1, scr, gw, NGW, lane);
            convert_job(P.w_v, P.kv_norm_g, D, D, (bf16_t*)(ws + WS_WA) + (size_t)2 * D * D, 2 * q1, scr, gw, NGW, lane);
        }
        convert_job(P.b_w_o + (size_t)j * D * D, nullptr, D, D, (bf16_t*)(ws + WS_WB), 3 * q1, scr, gw, NGW, lane);
    }
    convert_job(P.w_up + (size_t)layer * D * FF, g + 2 * D, D, FF, (bf16_t*)(ws + WS_WUP), 0, scr, gw, NGW, lane);
    convert_job(P.w_down + (size_t)layer * FF * D, nullptr, FF, D, (bf16_t*)(ws + WS_WDN), 0, scr, gw, NGW, lane);
}

__device__ __forceinline__ void rowpass0(int gw, int NGW, int lane, const float* x, bf16_t* hb, float* rstd) {
    for (int row0 = gw * 4; row0 < M; row0 += NGW * 4) {
        f32x4 hv[4][4]; float sq[4];
#pragma unroll
        for (int rr = 0; rr < 4; ++rr)
#pragma unroll
            for (int j = 0; j < 4; ++j) hv[rr][j] = *(const f32x4*)(x + (size_t)(row0 + rr) * D + 4 * lane + 256 * j);
#pragma unroll
        for (int rr = 0; rr < 4; ++rr) { float s = 0.f;
#pragma unroll
            for (int j = 0; j < 4; ++j) s += (hv[rr][j][0] * hv[rr][j][0] + hv[rr][j][1] * hv[rr][j][1]) + (hv[rr][j][2] * hv[rr][j][2] + hv[rr][j][3] * hv[rr][j][3]);
            sq[rr] = s; }
#pragma unroll
        for (int o = 1; o < 64; o <<= 1) { sq[0] += __shfl_xor(sq[0], o); sq[1] += __shfl_xor(sq[1], o); sq[2] += __shfl_xor(sq[2], o); sq[3] += __shfl_xor(sq[3], o); }
        if (lane < 4) { const float sv = lane == 0 ? sq[0] : lane == 1 ? sq[1] : lane == 2 ? sq[2] : sq[3]; rstd[row0 + lane] = 1.0f / sqrtf(sv * (1.0f / D) + 1e-6f); }
#pragma unroll
        for (int rr = 0; rr < 4; ++rr)
#pragma unroll
            for (int j = 0; j < 4; ++j) { u32x2 w; w.x = pk2(hv[rr][j][0], hv[rr][j][1]); w.y = pk2(hv[rr][j][2], hv[rr][j][3]); *(u32x2*)(hb + (size_t)(row0 + rr) * D + 4 * lane + 256 * j) = w; }
    }
}
__device__ __forceinline__ void rowpass(int gw, int NGW, int lane, bf16_t* hb, const bf16_t* mb, const float* psq, const float* g, float* rstd, float* fout) {
    f32x4 gv[4];
#pragma unroll
    for (int j = 0; j < 4; ++j) gv[j] = *(const f32x4*)(g + 4 * lane + 256 * j);
    for (int row0 = gw * 4; row0 < M; row0 += NGW * 4) {
        float mq = psq[(size_t)row0 * 16 + lane];
        u32x2 mr[4][4], hr[4][4];
#pragma unroll
        for (int rr = 0; rr < 4; ++rr)
#pragma unroll
            for (int j = 0; j < 4; ++j) { const size_t o = (size_t)(row0 + rr) * D + 4 * lane + 256 * j; mr[rr][j] = *(const u32x2*)(mb + o); hr[rr][j] = *(const u32x2*)(hb + o); }
        mq += __shfl_xor(mq, 1); mq += __shfl_xor(mq, 2); mq += __shfl_xor(mq, 4); mq += __shfl_xor(mq, 8);
        float sq[4]; f32x4 hv[4][4];
#pragma unroll
        for (int rr = 0; rr < 4; ++rr) {
            const float rm = 1.0f / sqrtf(__shfl(mq, 16 * rr) * (1.0f / D) + 1e-6f);
            float s = 0.f;
#pragma unroll
            for (int j = 0; j < 4; ++j) {
                f32x4 mv, h0; mv[0] = bflo(mr[rr][j].x); mv[1] = bfhi(mr[rr][j].x); mv[2] = bflo(mr[rr][j].y); mv[3] = bfhi(mr[rr][j].y);
                h0[0] = bflo(hr[rr][j].x); h0[1] = bfhi(hr[rr][j].x); h0[2] = bflo(hr[rr][j].y); h0[3] = bfhi(hr[rr][j].y);
                hv[rr][j] = h0 + mv * rm * gv[j];
                s += (hv[rr][j][0] * hv[rr][j][0] + hv[rr][j][1] * hv[rr][j][1]) + (hv[rr][j][2] * hv[rr][j][2] + hv[rr][j][3] * hv[rr][j][3]);
            }
            sq[rr] = s;
        }
        if (fout) {
#pragma unroll
            for (int rr = 0; rr < 4; ++rr)
#pragma unroll
                for (int j = 0; j < 4; ++j) *(f32x4*)(fout + (size_t)(row0 + rr) * D + 4 * lane + 256 * j) = hv[rr][j];
        } else {
#pragma unroll
            for (int o = 1; o < 64; o <<= 1) { sq[0] += __shfl_xor(sq[0], o); sq[1] += __shfl_xor(sq[1], o); sq[2] += __shfl_xor(sq[2], o); sq[3] += __shfl_xor(sq[3], o); }
            if (lane < 4) { const float sv = lane == 0 ? sq[0] : lane == 1 ? sq[1] : lane == 2 ? sq[2] : sq[3]; rstd[row0 + lane] = 1.0f / sqrtf(sv * (1.0f / D) + 1e-6f); }
#pragma unroll
            for (int rr = 0; rr < 4; ++rr)
#pragma unroll
                for (int j = 0; j < 4; ++j) { u32x2 w; w.x = pk2(hv[rr][j][0], hv[rr][j][1]); w.y = pk2(hv[rr][j][2], hv[rr][j][3]); *(u32x2*)(hb + (size_t)(row0 + rr) * D + 4 * lane + 256 * j) = w; }
        }
    }
}

__device__ __forceinline__ void gate_phase(LAS unsigned char* lds, int vcu, int G, const bf16_t* U, const bf16_t* VT, const float* psum, const float* psq,
                                           const float* lng, const float* lnb, const float* wsp, const float* bsp, bf16_t* UG, const int wave) {
    const int lane = opaque_lane(), tid = wave * 64 + lane, fr = lane & 15, fq = lane >> 4;
    LAS bf16_t* tile = (LAS bf16_t*)lds;
    LAS float* st = (LAS float*)(lds + 36864);
    for (int unit = vcu; unit < 1024; unit += G) {
        const int nb = unit >> 3, g = unit & 7, tok0 = nb * 128;
        __syncthreads();
        if (tid < 128) {
            float s = 0.f, q = 0.f;
#pragma unroll
            for (int p = 0; p < 8; ++p) { s += psum[(size_t)p * M + tok0 + tid]; q += psq[(size_t)p * M + tok0 + tid]; }
            const float mu = s * (1.0f / 1024), var = q * (1.0f / 1024) - mu * mu;
            st[2 * tid] = mu; st[2 * tid + 1] = 1.0f / sqrtf(fmaxf(var, 0.f) + 1e-5f);
        }
        __syncthreads();
#pragma unroll
        for (int r = 0; r < 4; ++r) {
            const int q = tid + 512 * r, d = q >> 4, jc = q & 15;
            const u32x4 raw = *(const u32x4*)(VT + (size_t)(g * 128 + d) * M + tok0 + 8 * jc);
            const float lg = lng[g * 128 + d], lb = lnb[g * 128 + d];
            const f32x4 s0 = *(const LAS f32x4*)(st + 16 * jc), s1 = *(const LAS f32x4*)(st + 16 * jc + 4), s2 = *(const LAS f32x4*)(st + 16 * jc + 8), s3 = *(const LAS f32x4*)(st + 16 * jc + 12);
            u32x4 o;
            o.x = pk2((bflo(raw.x) - s0[0]) * s0[1] * lg + lb, (bfhi(raw.x) - s0[2]) * s0[3] * lg + lb);
            o.y = pk2((bflo(raw.y) - s1[0]) * s1[1] * lg + lb, (bfhi(raw.y) - s1[2]) * s1[3] * lg + lb);
            o.z = pk2((bflo(raw.z) - s2[0]) * s2[1] * lg + lb, (bfhi(raw.z) - s2[2]) * s2[3] * lg + lb);
            o.w = pk2((bflo(raw.w) - s3[0]) * s3[1] * lg + lb, (bfhi(raw.w) - s3[2]) * s3[3] * lg + lb);
            *(LAS u32x4*)(tile + d * 136 + 8 * jc) = o;
        }
        __syncthreads();
        const int i0 = 16 * wave, nk = wave < 4 ? 2 : 4;
        bf16x8 wm[4];
#pragma unroll
        for (int ks = 0; ks < 4; ++ks) {
            u32x4 w = (u32x4){0u, 0u, 0u, 0u};
            if (ks < nk) { const float* wp = wsp + ((size_t)g * 128 + i0 + fr) * 128 + 32 * ks + 8 * fq; const f32x4 a = *(const f32x4*)wp, b = *(const f32x4*)(wp + 4);
                w.x = pk2(a[0], a[1]); w.y = pk2(a[2], a[3]); w.z = pk2(b[0], b[1]); w.w = pk2(b[2], b[3]); }
            wm[ks] = __builtin_bit_cast(bf16x8, w);
        }
        const float bias = bsp[g * 128 + i0 + fr];
#pragma unroll
        for (int dt = 0; dt < 8; ++dt) {
            f32x4 acc = (f32x4){0.f, 0.f, 0.f, 0.f};
#pragma unroll
            for (int ks = 0; ks < 4; ++ks) if (ks < nk) {
                const bf16x8 a = *(const LAS bf16x8*)(tile + (16 * dt + fr) * 136 + 32 * ks + 8 * fq);
                acc = __builtin_amdgcn_mfma_f32_16x16x32_bf16(a, wm[ks], acc, 0, 0, 0);
            }
            const size_t off = (size_t)(tok0 + i0 + fr) * D + g * 128 + 16 * dt + 4 * fq;
            const u32x2 uu = *(const u32x2*)(U + off);
            u32x2 o; o.x = pk2(bflo(uu.x) * (acc[0] + bias), bfhi(uu.x) * (acc[1] + bias)); o.y = pk2(bflo(uu.y) * (acc[2] + bias), bfhi(uu.y) * (acc[3] + bias));
            *(u32x2*)(UG + off) = o;
        }
    }
}

__device__ __forceinline__ int crow(int r, int hi) { return (r & 3) + 8 * (r >> 2) + 4 * hi; }
__device__ __forceinline__ bf16x8 ldg16(const bf16_t* base, unsigned byte_off) { return *(const bf16x8*)((const char*)base + byte_off); }
__device__ __forceinline__ void attn_phase(LAS unsigned char* lds, int vcu, int G, const bf16_t* Q, const bf16_t* K, const bf16_t* VTp, const float* tblg, bf16_t* O, const int wave) {
    const int lane = opaque_lane(), tid = wave * 64 + lane, r32 = lane & 31, hi = lane >> 5;
    LAS float* tb = (LAS float*)lds;
    __syncthreads();
    for (int i = tid; i < NH * 513; i += 512) { const int h = i / 513, j = i - h * 513; tb[h * 516 + j] = tblg[i] * LOG2E; }
    __syncthreads();
    const int gw = vcu * 8 + wave, NGW = G * 8;
    const unsigned rowoff = (unsigned)(r32 * D + 8 * hi) * 2u;
    const unsigned loff = (unsigned)lane * 16u;
    for (int idx = gw; idx < NBATCH * 64 * NH; idx += NGW) {
        const int h = idx & 15, c = (idx >> 4) & 63, b = idx >> 10;
        const int tok0 = b * SEQ + c * 64;
        const bf16_t* Qu = Q + (size_t)tok0 * D + h * 64;
        bf16x8 qf[2][4];
#pragma unroll
        for (int qh = 0; qh < 2; ++qh)
#pragma unroll
            for (int d0 = 0; d0 < 4; ++d0) qf[qh][d0] = ldg16(Qu + (size_t)qh * 32 * D + 16 * d0, rowoff);
        f32x16 o[2][2];
#pragma unroll
        for (int a = 0; a < 2; ++a)
#pragma unroll
            for (int e = 0; e < 2; ++e)
#pragma unroll
                for (int r = 0; r < 16; ++r) o[a][e][r] = 0.f;
        float mref[2] = {-1e30f, -1e30f}, lsum[2] = {0.f, 0.f};
        const LAS float* tbh = tb + h * 516;
        const int kc0 = c > 8 ? c - 8 : 0;
        const int nsteps = 2 * (c - kc0 + 1);
        const int ktok0 = b * SEQ + kc0 * 64;
        const bf16_t* Ku = K + ((size_t)(ktok0 >> 5) * 16 + h) * 2048;
        const bf16_t* Vu = VTp + ((size_t)(ktok0 >> 5) * 16 + h) * 2048;
        bf16x8 kf[4];
#pragma unroll
        for (int d0 = 0; d0 < 4; ++d0) kf[d0] = ldg16(Ku + 512 * d0, loff);
#pragma unroll 1
        for (int st = 0; st < nsteps; ++st) {
            bf16x8 vf[2][2];
#pragma unroll
            for (int e = 0; e < 2; ++e)
#pragma unroll
                for (int s2 = 0; s2 < 2; ++s2) vf[e][s2] = ldg16(Vu + (size_t)st * 32768 + (e * 2 + s2) * 512, loff);
            const int dc = c - kc0 - (st >> 1), kh = st & 1;
            const float binit = dc >= 5 ? tbh[512] : 0.f;
            f32x16 p[2];
#pragma unroll
            for (int qh = 0; qh < 2; ++qh) {
                f32x16 acc;
#pragma unroll
                for (int r = 0; r < 16; ++r) acc[r] = binit;
#pragma unroll
                for (int d0 = 0; d0 < 4; ++d0) acc = __builtin_amdgcn_mfma_f32_32x32x16_bf16(kf[d0], qf[qh][d0], acc, 0, 0, 0);
                p[qh] = acc;
            }
            if (st + 1 < nsteps) {
#pragma unroll
                for (int d0 = 0; d0 < 4; ++d0) kf[d0] = ldg16(Ku + (size_t)(st + 1) * 32768 + 512 * d0, loff);
            }
            if (dc < 5) {
                const int dbase = 64 * dc - 32 * kh + r32 - 4 * hi + 256;
#pragma unroll
                for (int qh = 0; qh < 2; ++qh) {
                    f32x16 bv;
#pragma unroll
                    for (int r = 0; r < 16; ++r) {
                        int di = dbase + 32 * qh - ((r & 3) + 8 * (r >> 2));
                        di = di > 512 ? 512 : di;
                        bv[r] = tbh[di];
                    }
                    p[qh] = p[qh] + bv;
                }
            }
            float mt[2];
#pragma unroll
            for (int qh = 0; qh < 2; ++qh) {
                float a = fmaxf(fmaxf(p[qh][0], p[qh][1]), p[qh][2]), b2 = fmaxf(fmaxf(p[qh][3], p[qh][4]), p[qh][5]);
                a = fmaxf(fmaxf(a, p[qh][6]), p[qh][7]); b2 = fmaxf(fmaxf(b2, p[qh][8]), p[qh][9]);
                a = fmaxf(fmaxf(a, p[qh][10]), p[qh][11]); b2 = fmaxf(fmaxf(b2, p[qh][12]), p[qh][13]);
                a = fmaxf(fmaxf(a, p[qh][14]), p[qh][15]);
                a = fmaxf(a, b2);
                mt[qh] = fmaxf(a, __shfl_xor(a, 32));
            }
            if (__any((mt[0] > mref[0] + 8.0f) || (mt[1] > mref[1] + 8.0f))) {
#pragma unroll
                for (int qh = 0; qh < 2; ++qh) {
                    const float mn = fmaxf(mref[qh], mt[qh]), f = __builtin_amdgcn_exp2f(mref[qh] - mn);
                    mref[qh] = mn; lsum[qh] *= f;
                    o[qh][0] = o[qh][0] * f; o[qh][1] = o[qh][1] * f;
                }
            }
            bf16x8 pb[2][2];
#pragma unroll
            for (int qh = 0; qh < 2; ++qh) {
                f32x16 e = p[qh] - mref[qh];
#pragma unroll
                for (int r = 0; r < 16; ++r) e[r] = __builtin_amdgcn_exp2f(e[r]);
                const f32x4 q4 = (f32x4){e[0], e[1], e[2], e[3]} + (f32x4){e[4], e[5], e[6], e[7]} + (f32x4){e[8], e[9], e[10], e[11]} + (f32x4){e[12], e[13], e[14], e[15]};
                lsum[qh] += (q4[0] + q4[1]) + (q4[2] + q4[3]);
#pragma unroll
                for (int s2 = 0; s2 < 2; ++s2) {
                    const int r0 = 8 * s2;
                    u32x4 w; w.x = pk2(e[r0 + 0], e[r0 + 1]); w.y = pk2(e[r0 + 2], e[r0 + 3]); w.z = pk2(e[r0 + 4], e[r0 + 5]); w.w = pk2(e[r0 + 6], e[r0 + 7]);
                    pb[qh][s2] = __builtin_bit_cast(bf16x8, w);
                }
            }
#pragma unroll
            for (int e = 0; e < 2; ++e)
#pragma unroll
                for (int s2 = 0; s2 < 2; ++s2)
#pragma unroll
                    for (int qh = 0; qh < 2; ++qh) o[qh][e] = __builtin_amdgcn_mfma_f32_32x32x16_bf16(vf[e][s2], pb[qh][s2], o[qh][e], 0, 0, 0);
        }
#pragma unroll
        for (int qh = 0; qh < 2; ++qh) {
            const float lt = lsum[qh] + __shfl_xor(lsum[qh], 32), inv = 1.0f / lt;
            char* op = (char*)(O + (size_t)(tok0 + 32 * qh) * D + h * 64) + (unsigned)(r32 * D + 4 * hi) * 2u;
#pragma unroll
            for (int e = 0; e < 2; ++e)
#pragma unroll
                for (int a = 0; a < 4; ++a) {
                    u32x2 w; w.x = pk2(o[qh][e][4 * a + 0] * inv, o[qh][e][4 * a + 1] * inv); w.y = pk2(o[qh][e][4 * a + 2] * inv, o[qh][e][4 * a + 3] * inv);
                    *(u32x2*)(op + (32 * e + 8 * a) * 2) = w;
                }
        }
    }
}

#define XB_TMO      128
#define XB_XCNT(j)  (256  + 64 * (j))
#define XB_XSUB(j)  (1280 + 64 * (j))
#define XB_XGEN(j)  (2304 + 64 * (j))
#define XB_TOP      3328
#define XB_TOPGEN   3392
#define XCD_BAR_WORDS 3456
#define XB_SPIN_CAP (1u << 18)

__device__ __forceinline__ unsigned xb_ld(unsigned* p)              { return __hip_atomic_load(p, __ATOMIC_RELAXED, __HIP_MEMORY_SCOPE_AGENT); }
__device__ __forceinline__ unsigned xb_add(unsigned* p, unsigned v) { return __hip_atomic_fetch_add(p, v, __ATOMIC_RELAXED, __HIP_MEMORY_SCOPE_AGENT); }
__device__ __forceinline__ unsigned xb_xcc_id() { return (unsigned)__builtin_amdgcn_s_getreg((3 << 11) | 20) & 0xFu; }
#define XB_SPIN(cond, bar) do { unsigned _sp = 0; while (cond) { __builtin_amdgcn_s_sleep(1); \
    if ((++_sp & 255u) == 0u) { if (xb_ld(&(bar)[XB_TMO])) break; if (_sp > XB_SPIN_CAP) { atomicAdd(&(bar)[XB_TMO], 1u); break; } } } } while (0)

struct XcdBarrier {
    unsigned* bar; unsigned x;
    volatile LAS unsigned* st;
};

__device__ __forceinline__ XcdBarrier xcd_barrier_post(unsigned* bar, volatile LAS unsigned* st) {
    XcdBarrier b; b.bar = bar; b.x = xb_xcc_id(); b.st = st;
    if (threadIdx.x == 0) (void)xb_add(&bar[XB_XCNT(b.x)], 1u);
    return b;
}
__device__ __forceinline__ void xcd_barrier_complete(unsigned* bar, unsigned x, unsigned& nloc, unsigned& nx) {
    const unsigned G = gridDim.x * gridDim.y * gridDim.z;
    unsigned sum, cnt, mine, sp = 0u;
    for (;;) {
        sum = 0u; cnt = 0u; mine = 0u;
#pragma unroll
        for (unsigned j = 0; j < 16; ++j) { const unsigned c = xb_ld(&bar[XB_XCNT(j)]); sum += c; cnt += (c > 0u) ? 1u : 0u; mine = (j == x) ? c : mine; }
        if (sum == G) break;
        __builtin_amdgcn_s_sleep(1);
        if ((++sp & 255u) == 0u) { if (xb_ld(&bar[XB_TMO])) break; if (sp > XB_SPIN_CAP) { atomicAdd(&bar[XB_TMO], 1u); break; } }
    }
    nloc = mine > 0u ? mine : 1u; nx = cnt > 0u ? cnt : 1u;
}

__device__ __forceinline__ void xcd_barrier(const XcdBarrier& b) {
    asm volatile("s_waitcnt vmcnt(0)" ::: "memory");
    __syncthreads();
    if (threadIdx.x == 0) {
        unsigned* bar = b.bar;
        __builtin_amdgcn_s_waitcnt(0);
        unsigned nloc = b.st[0], nx = b.st[1];
        if (nloc == 0u) { xcd_barrier_complete(bar, b.x, nloc, nx); b.st[0] = nloc; b.st[1] = nx; }
        const unsigned old = xb_add(&bar[XB_XSUB(b.x)], 1u);
        const unsigned gen = old / nloc;
        if (old + 1u == (gen + 1u) * nloc) {
            __builtin_amdgcn_fence(__ATOMIC_RELEASE, "agent");
            asm volatile("s_waitcnt vmcnt(0)" ::: "memory");
            const unsigned og = xb_add(&bar[XB_TOP], 1u);
            const unsigned tg = og / nx;
            if (og + 1u == (tg + 1u) * nx) xb_add(&bar[XB_TOPGEN], 1u);
            else XB_SPIN(xb_ld(&bar[XB_TOPGEN]) == tg, bar);
            __builtin_amdgcn_fence(__ATOMIC_ACQUIRE, "agent");
            xb_add(&bar[XB_XGEN(b.x)], 1u);
            asm volatile("s_waitcnt vmcnt(0)" ::: "memory");
        } else {
            XB_SPIN(xb_ld(&bar[XB_XGEN(b.x)]) == gen, bar);
            __builtin_amdgcn_fence(__ATOMIC_ACQUIRE, "agent");
            asm volatile("s_waitcnt vmcnt(0)" ::: "memory");
        }
    }
    __syncthreads();
}

#define WSB(off) (opaque_ptr(P.ws) + (off))
__global__ void __launch_bounds__(512, 2) mega_fwd(Params P) {
    extern __shared__ __attribute__((aligned(16))) unsigned char lds_raw[];
    LAS unsigned char* lds = (LAS unsigned char*)lds_raw;
    const int wave = __builtin_amdgcn_readfirstlane((int)threadIdx.x >> 6);
    const int G = gridDim.x, bx = blockIdx.x;
    const int vcu = (G % 8 == 0) ? (bx % 8) * (G / 8) + bx / 8 : bx;
    const int gw = vcu * 8 + wave, NGW = G * 8;
    LAS float* scr = (LAS float*)(lds + wave * 16384);
    volatile LAS unsigned* misc = (volatile LAS unsigned*)(lds + LDS_MISC);
    if (threadIdx.x < 2) misc[threadIdx.x] = 0u;
    __syncthreads();
    const XcdBarrier bar = xcd_barrier_post((unsigned*)(P.ws + WS_BAR), misc);

    convert_layer(P, 0, scr, gw, NGW, opaque_lane());
    rowpass0(gw, NGW, opaque_lane(), P.x, (bf16_t*)WSB(WS_HB), (float*)WSB(WS_RSTD));
    cg::this_grid().sync();

#pragma unroll 1
    for (int layer = 0; layer < 4; ++layer) {
        const float* g = P.norm_g + (size_t)layer * 4 * D;
        if (layer < 2) {
            {
                unsigned char* ws = WSB(0);
                pg8::Gemm gm{(bf16_t*)(ws + WS_HB), (bf16_t*)(ws + WS_WA), M, D, D}; pg8::StaticOrder S; S.init(M, D, G, bx);
                pg8::EpiRow<1> E{(bf16_t*)(ws + WS_U), nullptr, D, 1 << 20, (float*)(ws + WS_RSTD), 1.0f};
                pg8::gemm_phase<pg8::EpiRow<1>, pg8::StaticOrder, true, true>(lds, gm, S, E, wave);
            }
            {
                unsigned char* ws = WSB(0);
                pg8::Gemm gm{(bf16_t*)(ws + WS_WA) + (size_t)D * D, (bf16_t*)(ws + WS_HB), D, M, D}; pg8::StaticOrder S; S.init(D, M, G, bx);
                pg8::EpiCol<0> E{(bf16_t*)(ws + WS_VT), M, (float*)(ws + WS_RSTD), (float*)(ws + WS_LNS), (float*)(ws + WS_LNQ)};
                pg8::gemm_phase<pg8::EpiCol<0>, pg8::StaticOrder, true, true>(lds, gm, S, E, wave);
            }
        } else {
            {
                unsigned char* ws = WSB(0);
                const int N = layer == 2 ? 2 * D : D;
                pg8::Gemm gm{(bf16_t*)(ws + WS_HB), (bf16_t*)(ws + WS_WA), M, N, D}; pg8::StaticOrder S; S.init(M, N, G, bx);
                pg8::EpiRow<0> E{(bf16_t*)(ws + WS_Q), (bf16_t*)(ws + WS_K), D, 4, (float*)(ws + WS_RSTD), QSCALE};
                pg8::gemm_phase<pg8::EpiRow<0>, pg8::StaticOrder, true, true>(lds, gm, S, E, wave);
            }
            if (layer == 2) {
                unsigned char* ws = WSB(0);
                pg8::Gemm gm{(bf16_t*)(ws + WS_WA) + (size_t)2 * D * D, (bf16_t*)(ws + WS_HB), D, M, D}; pg8::StaticOrder S; S.init(D, M, G, bx);
                pg8::EpiCol<1> E{(bf16_t*)(ws + WS_VTA), M, (float*)(ws + WS_RSTD), nullptr, nullptr};
                pg8::gemm_phase<pg8::EpiCol<1>, pg8::StaticOrder, true, true>(lds, gm, S, E, wave);
            }
        }
        xcd_barrier(bar);
        if (layer < 2) {
            unsigned char* ws = WSB(0);
            gate_phase(lds, vcu, G, (const bf16_t*)(ws + WS_U), (const bf16_t*)(ws + WS_VT), (const float*)(ws + WS_LNS), (const float*)(ws + WS_LNQ), P.a_ln_g + layer * D, P.a_ln_b + layer * D,
                       P.a_w_s + (size_t)layer * 8 * 128 * 128, P.a_b_s + layer * 8 * 128, (bf16_t*)(ws + WS_UG), wave);
        } else {
            unsigned char* ws = WSB(0);
            attn_phase(lds, vcu, G, (const bf16_t*)(ws + WS_Q), (const bf16_t*)(ws + WS_K), (const bf16_t*)(ws + WS_VTA), P.b_rel + (size_t)(layer - 2) * NH * 513, (bf16_t*)(ws + WS_O), wave);
        }
        xcd_barrier(bar);
        {
            unsigned char* ws = WSB(0);
            pg8::Gemm gm{layer < 2 ? (const bf16_t*)(ws + WS_UG) : (const bf16_t*)(ws + WS_O), (bf16_t*)(ws + WS_WB), M, D, D}; pg8::StaticOrder S; S.init(M, D, G, bx);
            pg8::EpiSq E{(bf16_t*)(ws + WS_U), D, (float*)(ws + WS_PSQ)};
            pg8::gemm_phase<pg8::EpiSq, pg8::StaticOrder, true, true>(lds, gm, S, E, wave);
        }
        xcd_barrier(bar);
        { unsigned char* ws = WSB(0); rowpass(gw, NGW, opaque_lane(), (bf16_t*)(ws + WS_HB), (const bf16_t*)(ws + WS_U), (const float*)(ws + WS_PSQ), g + D, (float*)(ws + WS_RSTD), nullptr); }
        xcd_barrier(bar);
        {
            unsigned char* ws = WSB(0);
            pg8::Gemm gm{(bf16_t*)(ws + WS_HB), (bf16_t*)(ws + WS_WUP), M, FF, D}; pg8::StaticOrder S; S.init(M, FF, G, bx);
            pg8::EpiRow<2> E{(bf16_t*)(ws + WS_T), nullptr, FF, 1 << 20, (float*)(ws + WS_RSTD), 1.0f};
            pg8::gemm_phase<pg8::EpiRow<2>, pg8::StaticOrder, true, true>(lds, gm, S, E, wave);
        }
        xcd_barrier(bar);
        {
            unsigned char* ws = WSB(0);
            pg8::Gemm gm{(bf16_t*)(ws + WS_T), (bf16_t*)(ws + WS_WDN), M, D, FF}; pg8::StaticOrder S; S.init(M, D, G, bx);
            pg8::EpiSq E{layer < 3 ? (bf16_t*)opaque_ptr(P.out) : (bf16_t*)(ws + WS_K), D, (float*)(ws + WS_PSQ)};
            pg8::gemm_phase<pg8::EpiSq, pg8::StaticOrder, true, true>(lds, gm, S, E, wave);
        }
        xcd_barrier(bar);
        { unsigned char* ws = WSB(0); rowpass(gw, NGW, opaque_lane(), (bf16_t*)(ws + WS_HB), layer < 3 ? (const bf16_t*)opaque_ptr(P.out) : (const bf16_t*)(ws + WS_K), (const float*)(ws + WS_PSQ), g + 3 * D, (float*)(ws + WS_RSTD), layer < 3 ? nullptr : P.out); }
        if (layer < 3) { convert_layer(P, layer + 1, scr, gw, NGW, opaque_lane()); xcd_barrier(bar); }
    }
}

extern "C" void kernel_launch(void* const* d_in, const int* in_sizes, int n_in, void* d_out, int out_size, void* d_ws, size_t ws_size, hipStream_t stream) {
    static int grid = 0;
    if (grid == 0) {
        if (n_in != 16 || out_size != M * D || ws_size < WS_END) { fprintf(stderr, "kernel_launch: unexpected shapes: n_in %d out %d ws %zu\n", n_in, out_size, ws_size); grid = -1; return; }
        int dev = 0, cus = 0, per_cu = 0;
        if (hipGetDevice(&dev) != hipSuccess || hipDeviceGetAttribute(&cus, hipDeviceAttributeMultiprocessorCount, dev) != hipSuccess) { grid = -1; return; }
        if (hipFuncSetAttribute((const void*)mega_fwd, hipFuncAttributeMaxDynamicSharedMemorySize, LDS_BYTES) != hipSuccess) { fprintf(stderr, "kernel_launch: hipFuncSetAttribute failed\n"); grid = -1; return; }
        if (hipOccupancyMaxActiveBlocksPerMultiprocessor(&per_cu, (const void*)mega_fwd, 512, LDS_BYTES) != hipSuccess || per_cu < 1) { fprintf(stderr, "kernel_launch: occupancy query failed (%d)\n", per_cu); grid = -1; return; }
        grid = cus * per_cu;
        fprintf(stderr, "kernel_launch: grid %d (%d CUs x %d)\n", grid, cus, per_cu);
    }
    if (grid < 0) return;
    Params p{};
    p.x = (const float*)d_in[0]; p.norm_g = (const float*)d_in[1]; p.a_w_in = (const float*)d_in[2]; p.a_ln_g = (const float*)d_in[3]; p.a_ln_b = (const float*)d_in[4];
    p.a_w_s = (const float*)d_in[5]; p.a_b_s = (const float*)d_in[6]; p.a_w_out = (const float*)d_in[7]; p.kv_norm_g = (const float*)d_in[8]; p.w_k = (const float*)d_in[9];
    p.w_v = (const float*)d_in[10]; p.b_w_q = (const float*)d_in[11]; p.b_rel = (const float*)d_in[12]; p.b_w_o = (const float*)d_in[13]; p.w_up = (const float*)d_in[14]; p.w_down = (const float*)d_in[15];
    p.out = (float*)d_out; p.ws = (unsigned char*)d_ws;
    if (hipMemsetAsync((char*)d_ws + WS_BAR, 0, BAR_ZERO_BYTES, stream) != hipSuccess) { fprintf(stderr, "kernel_launch: memset failed\n"); return; }
    void* args[] = {&p};
    const hipError_t e = hipLaunchCooperativeKernel((const void*)mega_fwd, dim3(grid), dim3(512), args, LDS_BYTES, stream);
    if (e != hipSuccess) fprintf(stderr, "kernel_launch: cooperative launch failed: %s (grid %d)\n", hipGetErrorString(e), grid);
}
```
